# Optimizing an MI355X kernel written in HIP

```python
import math
import jax, jax.numpy as jnp
from jax import lax
import numpy as np

D_MODEL = 1024
BATCH = 8
SEQ = 4096
DEPTH = 1

HEAD_DIM = 64
N_Q_HEADS = 8
N_KV_HEADS = 2
Q_PER_KV = N_Q_HEADS // N_KV_HEADS
ATTN_WIDTH = N_Q_HEADS * HEAD_DIM
KV_WIDTH = N_KV_HEADS * HEAD_DIM
WINDOW = 128
BLOCK = 128
N_BUCKETS = 32
MAX_DISTANCE = 128
CONV_WIDTH = D_MODEL - ATTN_WIDTH
CONV_GROUPS = 8
CONV_K = 3
IN_PROJ_WIDTH = ATTN_WIDTH + 2 * KV_WIDTH + 3 * CONV_WIDTH
D_FF = -(-8 * D_MODEL // (3 * 256)) * 256
N_MOD = 6
EPS = 1e-6
NEG_INF = -1e30

kernel_name = "hymba_swa_sink_shortconv_adaln_block"


def rmsnorm(x, g):
    xf = x.astype(jnp.float32)
    y = xf * lax.rsqrt(jnp.mean(xf * xf, axis=-1, keepdims=True) + EPS)
    return (y * g.astype(jnp.float32)).astype(x.dtype)


def t5_bucket(dist):
    max_exact = N_BUCKETS // 2
    is_small = dist < max_exact
    d = jnp.maximum(dist, 1).astype(jnp.float32)
    large = max_exact + (jnp.log(d / max_exact) / math.log(MAX_DISTANCE / max_exact)
                         * (N_BUCKETS - max_exact)).astype(jnp.int32)
    large = jnp.minimum(large, N_BUCKETS - 1)
    return jnp.where(is_small, dist, large)


def banded_sink_attention(q, k, v, sinks, rel_bias):
    b, s = q.shape[0], q.shape[1]
    nb = s // BLOCK
    qb = q.reshape(b, nb, BLOCK, N_KV_HEADS, Q_PER_KV, HEAD_DIM)
    kb = k.reshape(b, nb, BLOCK, N_KV_HEADS, HEAD_DIM)
    vb = v.reshape(b, nb, BLOCK, N_KV_HEADS, HEAD_DIM)

    def with_prev(t):
        prev = jnp.concatenate([jnp.zeros_like(t[:, :1]), t[:, :-1]], axis=1)
        return jnp.concatenate([prev, t], axis=2)

    kw, vw = with_prev(kb), with_prev(vb)
    scores = jnp.einsum("bnqkgd,bnskd->bnkgqs", qb, kw).astype(jnp.float32) * (HEAD_DIM ** -0.5)

    qi = jnp.arange(BLOCK, dtype=jnp.int32)[:, None]
    sj = jnp.arange(2 * BLOCK, dtype=jnp.int32)[None, :]
    dist = qi + BLOCK - sj
    bias = rel_bias[t5_bucket(jnp.maximum(dist, 0))]
    bias = jnp.transpose(bias, (2, 0, 1)).reshape(N_KV_HEADS, Q_PER_KV, BLOCK, 2 * BLOCK)
    scores = scores + bias.astype(jnp.float32)

    in_window = (dist >= 0) & (dist < WINDOW)
    key_pos = jnp.arange(nb, dtype=jnp.int32)[:, None] * BLOCK - BLOCK + sj
    valid = in_window[None] & (key_pos >= 0)[:, None, :]
    scores = jnp.where(valid[None, :, None, None], scores, NEG_INF)

    sink = sinks.astype(jnp.float32).reshape(N_KV_HEADS, Q_PER_KV)[None, None, :, :, None, None]
    m = jnp.maximum(jnp.max(scores, axis=-1, keepdims=True), sink)
    p = jnp.exp(scores - m)
    p = p / (jnp.sum(p, axis=-1, keepdims=True) + jnp.exp(sink - m))
    out = jnp.einsum("bnkgqs,bnskd->bnqkgd", p.astype(v.dtype), vw)
    return out.reshape(b, s, ATTN_WIDTH)


def causal_short_conv(u, w):
    s = u.shape[1]
    up = jnp.pad(u, ((0, 0), (CONV_K - 1, 0), (0, 0)))
    return w[0] * up[:, 0:s] + w[1] * up[:, 1:s + 1] + w[2] * up[:, 2:s + 2]


def setup_inputs(seed: int = 0) -> dict:
    key = jax.random.key(seed)
    ks = jax.random.split(key, 20)
    f32 = jnp.float32
    n = lambda k, shape, scale: (jax.random.normal(k, shape, f32) * scale)
    return {
        "x": n(ks[0], (BATCH, SEQ, D_MODEL), 1.0),
        "c": n(ks[1], (BATCH, D_MODEL), 1.0),
        "rel_bias": n(ks[2], (N_BUCKETS, N_Q_HEADS), 0.5),
        "w_ada": n(ks[3], (DEPTH, D_MODEL, N_MOD * D_MODEL), D_MODEL ** -0.5),
        "b_ada": n(ks[4], (DEPTH, N_MOD * D_MODEL), 0.01),
        "g_norm1": 1.0 + n(ks[5], (DEPTH, D_MODEL), 0.02),
        "w_in": n(ks[6], (DEPTH, D_MODEL, IN_PROJ_WIDTH), D_MODEL ** -0.5),
        "sinks": n(ks[7], (DEPTH, N_Q_HEADS), 1.0),
        "conv_w": n(ks[8], (DEPTH, CONV_K, CONV_WIDTH), CONV_K ** -0.5),
        "g_attn_out": 1.0 + n(ks[9], (DEPTH, ATTN_WIDTH), 0.02),
        "g_conv_out": 1.0 + n(ks[10], (DEPTH, CONV_WIDTH), 0.02),
        "w_out": n(ks[11], (DEPTH, D_MODEL, D_MODEL), D_MODEL ** -0.5),
        "g_norm2": 1.0 + n(ks[12], (DEPTH, D_MODEL), 0.02),
        "w_gu": n(ks[13], (DEPTH, D_MODEL, 2 * D_FF), D_MODEL ** -0.5),
        "w_down": n(ks[14], (DEPTH, D_FF, D_MODEL), D_FF ** -0.5),
        "g_final": 1.0 + n(ks[15], (D_MODEL,), 0.02),
    }


def reference(x, c, rel_bias, w_ada, b_ada, g_norm1, w_in, sinks, conv_w, g_attn_out,
              g_conv_out, w_out, g_norm2, w_gu, w_down, g_final):
    b, s = x.shape[0], x.shape[1]
    cond = jax.nn.silu(c)
    splits = [ATTN_WIDTH, ATTN_WIDTH + KV_WIDTH, ATTN_WIDTH + 2 * KV_WIDTH,
              ATTN_WIDTH + 2 * KV_WIDTH + CONV_WIDTH, ATTN_WIDTH + 2 * KV_WIDTH + 2 * CONV_WIDTH]
    for l in range(DEPTH):
        mod = (cond @ w_ada[l] + b_ada[l])[:, None, :]
        sh1, sc1, g1, sh2, sc2, g2 = jnp.split(mod, N_MOD, axis=-1)

        h = rmsnorm(x, g_norm1[l]) * (1.0 + sc1) + sh1
        proj = h @ w_in[l]
        q, k, v, gate_b, gate_c, xc = jnp.split(proj, splits, axis=-1)
        q = q.reshape(b, s, N_Q_HEADS, HEAD_DIM)
        k = k.reshape(b, s, N_KV_HEADS, HEAD_DIM)
        v = v.reshape(b, s, N_KV_HEADS, HEAD_DIM)
        attn = banded_sink_attention(q, k, v, sinks[l], rel_bias)
        conv = gate_b * causal_short_conv(gate_c * xc, conv_w[l])
        merged = jnp.concatenate([rmsnorm(attn, g_attn_out[l]), rmsnorm(conv, g_conv_out[l])], axis=-1)
        x = x + g1 * (merged @ w_out[l])

        h2 = rmsnorm(x, g_norm2[l]) * (1.0 + sc2) + sh2
        gate, up = jnp.split(h2 @ w_gu[l], 2, axis=-1)
        x = x + g2 * ((jax.nn.silu(gate) * up) @ w_down[l])
    return rmsnorm(x, g_final)
```

```cpp
#include <hip/hip_runtime.h>
#include <cstdio>
#include <cstdint>
#define MK_N_LAUNCHES 1
namespace pg8 {
#define PG8_LAS __attribute__((address_space(3)))
typedef unsigned short bf16_t;
typedef short bf16x8 __attribute__((ext_vector_type(8)));
typedef float f32x4 __attribute__((ext_vector_type(4)));
typedef unsigned u32x4 __attribute__((ext_vector_type(4)));
constexpr int BM = 256, BK = 64, HALF = 128, HTB = HALF * BK * 2  , STAGE_BYTES = 8 * HTB, NXCD = 8, WGM = 8;

__host__ __device__ __forceinline__ int lds_byte(int r, int c) { const int st = (r >> 4) * 2 + (c >> 5), rr = r & 15, cc = c & 31, ob = rr * 64 + cc * 2; return st * 1024 + (ob ^ (((ob >> 9) & 1) << 5)); }
__host__ __device__ __forceinline__ void stage_rc(int b, int& R, int& C) { const int st = b / 1024, sb = b % 1024, swz = sb ^ (((sb >> 9) & 1) << 5); R = (st >> 1) * 16 + swz / 64; C = (st & 1) * 32 + (swz % 64) / 2; }
__host__ __device__ __forceinline__ int perm32(int rho) { const int n = rho >> 4, i = rho & 15; return 8 * (i >> 2) + 4 * n + (i & 3); }

struct Unit { int pm, pn; };
struct Gemm { const bf16_t* A; const bf16_t* Bt; int M, N, K; };

struct StaticOrder {
    int nM, nN, nwg, G, c;
    __host__ __device__ void init(int M, int N, int G_, int c_) { nM = M / BM; nN = N / BM; nwg = nM * nN; G = G_; c = c_; }
    __host__ __device__ bool next(int i, Unit& u) const {
        const long L = (long)i * G + c; if (L >= nwg) return false;
        int wgid = (int)L; { const int q = nwg / NXCD, r = nwg % NXCD, xcd = wgid % NXCD, off = wgid / NXCD; wgid = (xcd < r ? xcd * (q + 1) : r * (q + 1) + (xcd - r) * q) + off; }
        const int nig = WGM * nN, gid = wgid / nig, fm = gid * WGM, gsz = (nM - fm) < WGM ? (nM - fm) : WGM;
        u.pm = fm + ((wgid % nig) % gsz); u.pn = (wgid % nig) / gsz; return true;
    }
    __device__ __forceinline__ void a_ready(const Unit&) const {}
    __device__ __forceinline__ void done(const Unit&) const {}
};

__device__ __forceinline__ unsigned cvt_pk_bf16(float lo, float hi) { unsigned r; asm volatile("v_cvt_pk_bf16_f32 %0, %1, %2" : "=v"(r) : "v"(lo), "v"(hi)); return r; }
typedef float f32x2 __attribute__((ext_vector_type(2)));
template <class Epi, class Sched, bool ALIGN_EPI = false, bool SP2 = false>
__device__ __forceinline__ void gemm_phase(PG8_LAS unsigned char* lds, const Gemm g, const Sched& S, const Epi& E) {
    const int tid = threadIdx.x, wid = __builtin_amdgcn_readfirstlane(tid >> 6), lane = tid & 63, wr = wid >> 2, wc = wid & 3, fr = lane & 15, fq = lane >> 4;
    const int K = g.K, nt = K / BK;
    unsigned voffA[2], voffB[2];
#pragma unroll
    for (int i = 0; i < 2; ++i) { int R, C; stage_rc(tid * 16 + i * 8192, R, C); const int Rb = Epi::PERM ? ((R & ~31) + perm32(R & 31)) : R;
        voffA[i] = (unsigned)(R * K + C) * 2u; voffB[i] = (unsigned)(Rb * K + C) * 2u; }
    const size_t kstep = (size_t)(BK * 2);
    const size_t hstep = (size_t)HALF * K * 2;
    const size_t tstep = 2 * hstep;
    const unsigned ldsw = (unsigned)wid * 1024u;
    const int aoff = lds_byte(wr * 64 + fr, fq * 8), boff = lds_byte(wc * 32 + fr, fq * 8);
#define PG8_SA(b, h) (((b) * 2 + (h)) * HTB)
#define PG8_SB(b, h) ((4 + (b) * 2 + (h)) * HTB)
#define PG8_STAGE(bufoff, gbase, voff) do { _Pragma("unroll") for (int _i = 0; _i < 2; ++_i) \
        __builtin_amdgcn_global_load_lds((const unsigned*)((const char*)(gbase) + (voff)[_i]), (PG8_LAS unsigned*)(lds + (bufoff) + ldsw + _i * 8192), 16, 0, 0); } while (0)
#define PG8_LDA(dst, b, h) do { _Pragma("unroll") for (int m = 0; m < 4; ++m) _Pragma("unroll") for (int k = 0; k < 2; ++k) dst[m][k] = *(const PG8_LAS bf16x8*)(lds + PG8_SA(b, h) + aoff + m * 2048 + k * 1024); } while (0)
#define PG8_LDB(dst, b, h) do { _Pragma("unroll") for (int n = 0; n < 2; ++n) _Pragma("unroll") for (int k = 0; k < 2; ++k) dst[n][k] = *(const PG8_LAS bf16x8*)(lds + PG8_SB(b, h) + boff + n * 2048 + k * 1024); } while (0)
#define PG8_MMA(ai, bj, At, Bt) do { __builtin_amdgcn_s_setprio(1); _Pragma("unroll") for (int m = 0; m < 4; ++m) _Pragma("unroll") for (int n = 0; n < 2; ++n) _Pragma("unroll") for (int k = 0; k < 2; ++k) \
        acc[ai][bj][m][n] = __builtin_amdgcn_mfma_f32_16x16x32_bf16(Bt[n][k], At[m][k], acc[ai][bj][m][n], 0, 0, 0); __builtin_amdgcn_s_setprio(0); } while (0)
#define PG8_WAIT_V(n) asm volatile("s_waitcnt vmcnt(" #n ")" ::: "memory")
#define PG8_WAIT_L(n) asm volatile("s_waitcnt lgkmcnt(" #n ")" ::: "memory")
#define PG8_BAR __builtin_amdgcn_s_barrier()
#define PG8_SCHED __builtin_amdgcn_sched_barrier(0)
    Unit cur, nxt; int ui = 0;
    if (!S.next(0, cur)) return;
    f32x4 acc[2][2][4][2];
#pragma unroll
    for (int a = 0; a < 2; ++a)
#pragma unroll
        for (int b = 0; b < 2; ++b)
#pragma unroll
            for (int m = 0; m < 4; ++m)
#pragma unroll
                for (int n = 0; n < 2; ++n) acc[a][b][m][n] = (f32x4){0.f, 0.f, 0.f, 0.f};
    bf16x8 At[4][2], B0[2][2], B1[2][2];
    const char* cA = (const char*)g.A + (size_t)cur.pm * tstep; const char* cB = (const char*)g.Bt + (size_t)cur.pn * tstep;
    S.a_ready(cur);
    if constexpr (SP2) {
        PG8_STAGE(PG8_SB(0, 0), cB, voffB); PG8_STAGE(PG8_SB(0, 1), cB + hstep, voffB); PG8_STAGE(PG8_SA(0, 0), cA, voffA); PG8_STAGE(PG8_SA(0, 1), cA + hstep, voffA);
        if (wr == 1) PG8_BAR;
        PG8_WAIT_V(2); PG8_BAR;
        PG8_STAGE(PG8_SB(1, 0), cB + kstep, voffB); PG8_STAGE(PG8_SA(1, 0), cA + kstep, voffA); PG8_STAGE(PG8_SB(1, 1), cB + hstep + kstep, voffB);
        PG8_WAIT_V(6); PG8_BAR;
    } else {
        PG8_STAGE(PG8_SB(0, 0), cB, voffB); PG8_STAGE(PG8_SA(0, 0), cA, voffA); PG8_STAGE(PG8_SB(0, 1), cB + hstep, voffB); PG8_STAGE(PG8_SA(0, 1), cA + hstep, voffA);
        if (wr == 1) PG8_BAR;
        PG8_WAIT_V(4); PG8_BAR;
        PG8_STAGE(PG8_SB(1, 0), cB + kstep, voffB); PG8_STAGE(PG8_SA(1, 0), cA + kstep, voffA); PG8_STAGE(PG8_SB(1, 1), cB + hstep + kstep, voffB);
        PG8_WAIT_V(6); PG8_BAR;
    }
    for (;;) {
        const bool has_next = S.next(ui + 1, nxt);
        const char* nA = has_next ? (const char*)g.A + (size_t)nxt.pm * tstep : cA; const char* nB = has_next ? (const char*)g.Bt + (size_t)nxt.pn * tstep : cB;
        for (int t = 0; t < nt; t += 2) {
            const bool last = (t == nt - 2);
            const char* a1 = cA + (size_t)(t + 1) * kstep;
            const char* a2 = last ? nA : cA + (size_t)(t + 2) * kstep; const char* b2 = last ? nB : cB + (size_t)(t + 2) * kstep;
            const char* a3 = a2 + kstep; const char* b3 = b2 + kstep;
            if (last && has_next) S.a_ready(nxt);
            if constexpr (SP2) {
            PG8_LDB(B0, 0, 0); PG8_LDB(B1, 0, 1); PG8_SCHED; PG8_LDA(At, 0, 0); PG8_STAGE(PG8_SA(1, 1), a1 + hstep, voffA);
            PG8_WAIT_V(8); PG8_WAIT_L(0); PG8_BAR; PG8_MMA(0, 0, At, B0); PG8_MMA(0, 1, At, B1); PG8_BAR; PG8_SCHED;
            PG8_LDA(At, 0, 1); PG8_STAGE(PG8_SB(0, 0), b2, voffB); PG8_STAGE(PG8_SB(0, 1), b2 + hstep, voffB); PG8_STAGE(PG8_SA(0, 0), a2, voffA);
            PG8_WAIT_V(8); PG8_WAIT_L(0); PG8_BAR; PG8_MMA(1, 0, At, B0); PG8_MMA(1, 1, At, B1); PG8_BAR; PG8_SCHED;
            PG8_LDB(B0, 1, 0); PG8_LDB(B1, 1, 1); PG8_SCHED; PG8_LDA(At, 1, 0); PG8_STAGE(PG8_SA(0, 1), a2 + hstep, voffA);
            PG8_WAIT_V(8); PG8_WAIT_L(0); PG8_BAR; PG8_MMA(0, 0, At, B0); PG8_MMA(0, 1, At, B1); PG8_BAR; PG8_SCHED;
            PG8_LDA(At, 1, 1); PG8_STAGE(PG8_SB(1, 0), b3, voffB); PG8_STAGE(PG8_SB(1, 1), b3 + hstep, voffB); PG8_STAGE(PG8_SA(1, 0), a3, voffA);
            PG8_WAIT_V(8); PG8_WAIT_L(0); PG8_BAR; PG8_MMA(1, 0, At, B0); PG8_MMA(1, 1, At, B1); PG8_BAR; PG8_SCHED;
            } else {
            PG8_LDB(B0, 0, 0); PG8_SCHED; PG8_LDA(At, 0, 0); PG8_STAGE(PG8_SA(1, 1), a1 + hstep, voffA);
            PG8_WAIT_L(8); PG8_BAR; PG8_WAIT_L(0); PG8_MMA(0, 0, At, B0); PG8_BAR; PG8_SCHED;
            PG8_LDB(B1, 0, 1); PG8_STAGE(PG8_SB(0, 0), b2, voffB);
            PG8_BAR; PG8_WAIT_L(0); PG8_MMA(0, 1, At, B1); PG8_BAR;
            PG8_LDA(At, 0, 1); PG8_STAGE(PG8_SA(0, 0), a2, voffA);
            PG8_BAR; PG8_WAIT_L(0); PG8_MMA(1, 0, At, B0); PG8_BAR; PG8_SCHED;
            PG8_STAGE(PG8_SB(0, 1), b2 + hstep, voffB);
            PG8_WAIT_V(6); PG8_BAR; PG8_MMA(1, 1, At, B1); PG8_BAR;
            PG8_LDB(B0, 1, 0); PG8_SCHED; PG8_LDA(At, 1, 0); PG8_STAGE(PG8_SA(0, 1), a2 + hstep, voffA);
            PG8_WAIT_L(8); PG8_BAR; PG8_WAIT_L(0); PG8_MMA(0, 0, At, B0); PG8_BAR; PG8_SCHED;
            PG8_LDB(B1, 1, 1); PG8_STAGE(PG8_SB(1, 0), b3, voffB);
            PG8_BAR; PG8_WAIT_L(0); PG8_MMA(0, 1, At, B1); PG8_BAR;
            PG8_LDA(At, 1, 1); PG8_STAGE(PG8_SA(1, 0), a3, voffA);
            PG8_BAR; PG8_WAIT_L(0); PG8_MMA(1, 0, At, B0); PG8_BAR; PG8_SCHED;
            PG8_STAGE(PG8_SB(1, 1), b3 + hstep, voffB);
            PG8_WAIT_V(6); PG8_BAR; PG8_MMA(1, 1, At, B1); PG8_BAR;
            }
        }
        if constexpr (ALIGN_EPI) { if (wr == 0) PG8_BAR; }
        if constexpr (!Epi::AFTER_DRAIN) { E(acc, cur, wr, wc, fr, fq); S.done(cur); }
        if (!has_next) break;
#pragma unroll
        for (int a = 0; a < 2; ++a)
#pragma unroll
            for (int b = 0; b < 2; ++b)
#pragma unroll
                for (int m = 0; m < 4; ++m)
#pragma unroll
                    for (int n = 0; n < 2; ++n) acc[a][b][m][n] = (f32x4){0.f, 0.f, 0.f, 0.f};
        cur = nxt; cA = nA; cB = nB; ++ui;
        if constexpr (ALIGN_EPI) { if (wr == 1) PG8_BAR; }
    }
    PG8_WAIT_V(0);
    if constexpr (!ALIGN_EPI) { if (wr == 0) PG8_BAR; }
    PG8_BAR;
    if constexpr (Epi::AFTER_DRAIN) { E.fused(acc, cur, wr, wc, fr, fq, lds, wid, lane); S.done(cur); }
#undef PG8_SA
#undef PG8_SB
#undef PG8_STAGE
#undef PG8_LDA
#undef PG8_LDB
#undef PG8_MMA
#undef PG8_WAIT_V
#undef PG8_WAIT_L
#undef PG8_BAR
#undef PG8_SCHED
}
}

namespace pg8 {
typedef unsigned u32x2 __attribute__((ext_vector_type(2)));
constexpr int E_SEQ = 4096, E_D = 1024, E_NPROJ = 2304, E_FF = 2816, E_NGU = 5632, E_NMOD = 6144;
constexpr float E_EPS = 1e-6f;

struct EpiProj {
    static constexpr bool PERM = true, AFTER_DRAIN = false;
    bf16_t* O; const float* rstd; const float* bias;
    __device__ __forceinline__ void operator()(const f32x4 (&acc)[2][2][4][2], const Unit& u, int wr, int wc, int fr, int fq) const {
        const int row0 = u.pm * BM + wr * 64 + fr, col0 = u.pn * BM + wc * 32 + 8 * fq;
        const int b = (u.pm * BM) / E_SEQ;
        const float* bp = bias + (size_t)b * E_NPROJ + col0;
        f32x4 bv[2][2];
#pragma unroll
        for (int bj = 0; bj < 2; ++bj)
#pragma unroll
            for (int n = 0; n < 2; ++n) bv[bj][n] = *(const f32x4*)(bp + bj * HALF + 4 * n);
#pragma unroll
        for (int ai = 0; ai < 2; ++ai)
#pragma unroll
            for (int m = 0; m < 4; ++m) { const int row = row0 + ai * HALF + m * 16; const float rs = rstd[row]; bf16_t* rowp = O + (size_t)row * E_NPROJ + col0;
#pragma unroll
                for (int bj = 0; bj < 2; ++bj) { const f32x4 v0 = acc[ai][bj][m][0] * rs + bv[bj][0], v1 = acc[ai][bj][m][1] * rs + bv[bj][1];
                    u32x4 w; w.x = cvt_pk_bf16(v0[0], v0[1]); w.y = cvt_pk_bf16(v0[2], v0[3]); w.z = cvt_pk_bf16(v1[0], v1[1]); w.w = cvt_pk_bf16(v1[2], v1[3]);
                    *(u32x4*)(rowp + bj * HALF) = w; } }
    }
};

struct EpiOut {
    static constexpr bool PERM = false, AFTER_DRAIN = false;
    const float* x; float* x1; bf16_t* a2; const float* mod; const float* gn2; float* ss;
    __device__ __forceinline__ void operator()(const f32x4 (&acc)[2][2][4][2], const Unit& u, int wr, int wc, int fr, int fq) const {
        const int row0 = u.pm * BM + wr * 64 + fr, col0 = u.pn * BM + wc * 32 + 4 * fq;
        const int b = (u.pm * BM) / E_SEQ;
        const float* g1p = mod + (size_t)b * E_NMOD + 2048 + col0; const float* sc2p = mod + (size_t)b * E_NMOD + 4096 + col0; const float* gnp = gn2 + col0;
        f32x4 g1v[2][2], gm[2][2];
#pragma unroll
        for (int bj = 0; bj < 2; ++bj)
#pragma unroll
            for (int n = 0; n < 2; ++n) { const int o = bj * HALF + n * 16; g1v[bj][n] = *(const f32x4*)(g1p + o); gm[bj][n] = *(const f32x4*)(gnp + o) * (*(const f32x4*)(sc2p + o) + 1.0f); }
#pragma unroll
        for (int ai = 0; ai < 2; ++ai)
#pragma unroll
            for (int m = 0; m < 4; ++m) { const int row = row0 + ai * HALF + m * 16; const size_t off = (size_t)row * E_D + col0; float s = 0.f;
#pragma unroll
                for (int bj = 0; bj < 2; ++bj)
#pragma unroll
                    for (int n = 0; n < 2; ++n) { const int o = bj * HALF + n * 16; const f32x4 xv = *(const f32x4*)(x + off + o); const f32x4 v = xv + g1v[bj][n] * acc[ai][bj][m][n];
                        *(f32x4*)(x1 + off + o) = v; s += (v[0] * v[0] + v[1] * v[1]) + (v[2] * v[2] + v[3] * v[3]);
                        const f32x4 w = v * gm[bj][n]; u32x2 p; p.x = cvt_pk_bf16(w[0], w[1]); p.y = cvt_pk_bf16(w[2], w[3]); *(u32x2*)(a2 + off + o) = p; }
                s += __shfl_xor(s, 16); s += __shfl_xor(s, 32);
                if (fq == 0) ss[(size_t)row * 16 + u.pn * 4 + wc] = s; }
    }
};

struct EpiGU {
    static constexpr bool PERM = true, AFTER_DRAIN = false;
    bf16_t* H; const float* ss; const float* bias;
    __device__ __forceinline__ void operator()(const f32x4 (&acc)[2][2][4][2], const Unit& u, int wr, int wc, int fr, int fq) const {
        const int row0 = u.pm * BM + wr * 64 + fr, colt = wc * 32 + 8 * fq;
        const int b = (u.pm * BM) / E_SEQ;
        const float* bp = bias + (size_t)b * E_NGU + u.pn * BM + colt;
        f32x4 bg[2], bu[2];
#pragma unroll
        for (int n = 0; n < 2; ++n) { bg[n] = *(const f32x4*)(bp + 4 * n); bu[n] = *(const f32x4*)(bp + HALF + 4 * n); }
#pragma unroll
        for (int ai = 0; ai < 2; ++ai)
#pragma unroll
            for (int m = 0; m < 4; ++m) { const int row = row0 + ai * HALF + m * 16;
                const f32x4* sp = (const f32x4*)(ss + (size_t)row * 16); const f32x4 s0 = sp[0], s1 = sp[1], s2 = sp[2], s3 = sp[3];
                const float tot = ((s0[0] + s0[1]) + (s0[2] + s0[3])) + ((s1[0] + s1[1]) + (s1[2] + s1[3])) + ((s2[0] + s2[1]) + (s2[2] + s2[3])) + ((s3[0] + s3[1]) + (s3[2] + s3[3]));
                const float rs = 1.0f / sqrtf(tot * (1.0f / E_D) + E_EPS);
                float hv[8];
#pragma unroll
                for (int n = 0; n < 2; ++n) { const f32x4 g = acc[ai][0][m][n] * rs + bg[n], up = acc[ai][1][m][n] * rs + bu[n];
#pragma unroll
                    for (int e = 0; e < 4; ++e) { const float sg = g[e] * __builtin_amdgcn_rcpf(1.0f + __builtin_amdgcn_exp2f(g[e] * -1.4426950408889634f)); hv[4 * n + e] = sg * up[e]; } }
                u32x4 w; w.x = cvt_pk_bf16(hv[0], hv[1]); w.y = cvt_pk_bf16(hv[2], hv[3]); w.z = cvt_pk_bf16(hv[4], hv[5]); w.w = cvt_pk_bf16(hv[6], hv[7]);
                *(u32x4*)(H + (size_t)row * E_FF + u.pn * HALF + colt) = w; }
    }
};

struct EpiDown {
    static constexpr bool PERM = false, AFTER_DRAIN = false;
    float* x1; const float* mod;
    __device__ __forceinline__ void operator()(const f32x4 (&acc)[2][2][4][2], const Unit& u, int wr, int wc, int fr, int fq) const {
        const int row0 = u.pm * BM + wr * 64 + fr, col0 = u.pn * BM + wc * 32 + 4 * fq;
        const int b = (u.pm * BM) / E_SEQ;
        const float* g2p = mod + (size_t)b * E_NMOD + 5120 + col0;
        f32x4 g2v[2][2];
#pragma unroll
        for (int bj = 0; bj < 2; ++bj)
#pragma unroll
            for (int n = 0; n < 2; ++n) g2v[bj][n] = *(const f32x4*)(g2p + bj * HALF + n * 16);
#pragma unroll
        for (int ai = 0; ai < 2; ++ai)
#pragma unroll
            for (int m = 0; m < 4; ++m) { const int row = row0 + ai * HALF + m * 16; const size_t off = (size_t)row * E_D + col0;
#pragma unroll
                for (int bj = 0; bj < 2; ++bj)
#pragma unroll
                    for (int n = 0; n < 2; ++n) { const int o = bj * HALF + n * 16; const f32x4 xv = *(const f32x4*)(x1 + off + o); *(f32x4*)(x1 + off + o) = xv + g2v[bj][n] * acc[ai][bj][m][n]; } }
    }
};
}
#define GAS __attribute__((address_space(1)))
#define LAS __attribute__((address_space(3)))
typedef unsigned short bf16;
typedef unsigned v4u __attribute__((ext_vector_type(4)));
typedef float f32x4 __attribute__((ext_vector_type(4)));
typedef short bf16x8 __attribute__((ext_vector_type(8)));
typedef GAS unsigned gu32;
typedef GAS unsigned long long gu64;
#define RLX_AGENT __ATOMIC_RELAXED, __HIP_MEMORY_SCOPE_AGENT
#define LDS_WAIT() asm volatile("s_waitcnt lgkmcnt(0)" ::: "memory")
#define VM_WAIT() asm volatile("s_waitcnt vmcnt(0)" ::: "memory")
__device__ __forceinline__ unsigned long long rt() { return __builtin_amdgcn_s_memrealtime(); }
__device__ __forceinline__ unsigned f2bf(float f) { unsigned u = __builtin_bit_cast(unsigned, f); return (u + 0x7fffu + ((u >> 16) & 1u)) >> 16; }
__device__ __forceinline__ unsigned pk2(float lo, float hi) { return f2bf(lo) | (f2bf(hi) << 16); }
#define XB_TMO      128
#define XB_XCNT(j)  (256  + 64 * (j))
#define XB_XSUB(j)  (1280 + 64 * (j))
#define XB_XGEN(j)  (2304 + 64 * (j))
#define XB_TOP      3328
#define XB_TOPGEN   3392
#define XCD_BAR_WORDS 3456
#define XB_SPIN_CAP (1u << 18)

__device__ __forceinline__ unsigned xb_ld(unsigned* p)              { return __hip_atomic_load(p, __ATOMIC_RELAXED, __HIP_MEMORY_SCOPE_AGENT); }
__device__ __forceinline__ unsigned xb_add(unsigned* p, unsigned v) { return __hip_atomic_fetch_add(p, v, __ATOMIC_RELAXED, __HIP_MEMORY_SCOPE_AGENT); }
__device__ __forceinline__ unsigned xb_xcc_id() { return (unsigned)__builtin_amdgcn_s_getreg((3 << 11) | 20) & 0xFu; }
#define XB_SPIN(cond, bar) do { unsigned _sp = 0; while (cond) { __builtin_amdgcn_s_sleep(1); \
    if ((++_sp & 255u) == 0u) { if (xb_ld(&(bar)[XB_TMO])) break; if (_sp > XB_SPIN_CAP) { atomicAdd(&(bar)[XB_TMO], 1u); break; } } } } while (0)

struct XcdBarrier {
    unsigned* bar; unsigned x;
    volatile LAS unsigned* st;
};

__device__ __forceinline__ XcdBarrier xcd_barrier_post(unsigned* bar, volatile LAS unsigned* st) {
    XcdBarrier b; b.bar = bar; b.x = xb_xcc_id(); b.st = st;
    if (threadIdx.x == 0) (void)xb_add(&bar[XB_XCNT(b.x)], 1u);
    return b;
}
__device__ __forceinline__ void xcd_barrier_complete(unsigned* bar, unsigned x, unsigned& nloc, unsigned& nx) {
    const unsigned G = gridDim.x * gridDim.y * gridDim.z;
    unsigned sum, cnt, mine, sp = 0u;
    for (;;) {
        sum = 0u; cnt = 0u; mine = 0u;
#pragma unroll
        for (unsigned j = 0; j < 16; ++j) { const unsigned c = xb_ld(&bar[XB_XCNT(j)]); sum += c; cnt += (c > 0u) ? 1u : 0u; mine = (j == x) ? c : mine; }
        if (sum == G) break;
        __builtin_amdgcn_s_sleep(1);
        if ((++sp & 255u) == 0u) { if (xb_ld(&bar[XB_TMO])) break; if (sp > XB_SPIN_CAP) { atomicAdd(&bar[XB_TMO], 1u); break; } }
    }
    nloc = mine > 0u ? mine : 1u; nx = cnt > 0u ? cnt : 1u;
}

__device__ __forceinline__ void xcd_barrier(const XcdBarrier& b) {
    asm volatile("s_waitcnt vmcnt(0)" ::: "memory");
    __syncthreads();
    if (threadIdx.x == 0) {
        unsigned* bar = b.bar;
        __builtin_amdgcn_s_waitcnt(0);
        unsigned nloc = b.st[0], nx = b.st[1];
        if (nloc == 0u) { xcd_barrier_complete(bar, b.x, nloc, nx); b.st[0] = nloc; b.st[1] = nx; }
        const unsigned old = xb_add(&bar[XB_XSUB(b.x)], 1u);
        const unsigned gen = old / nloc;
        if (old + 1u == (gen + 1u) * nloc) {
            __builtin_amdgcn_fence(__ATOMIC_RELEASE, "agent");
            asm volatile("s_waitcnt vmcnt(0)" ::: "memory");
            const unsigned og = xb_add(&bar[XB_TOP], 1u);
            const unsigned tg = og / nx;
            if (og + 1u == (tg + 1u) * nx) xb_add(&bar[XB_TOPGEN], 1u);
            else XB_SPIN(xb_ld(&bar[XB_TOPGEN]) == tg, bar);
            __builtin_amdgcn_fence(__ATOMIC_ACQUIRE, "agent");
            xb_add(&bar[XB_XGEN(b.x)], 1u);
            asm volatile("s_waitcnt vmcnt(0)" ::: "memory");
        } else {
            XB_SPIN(xb_ld(&bar[XB_XGEN(b.x)]) == gen, bar);
            __builtin_amdgcn_fence(__ATOMIC_ACQUIRE, "agent");
            asm volatile("s_waitcnt vmcnt(0)" ::: "memory");
        }
    }
    __syncthreads();
}

constexpr int NWAVES = 8;
#ifndef MK_N_LAUNCHES
#define MK_N_LAUNCHES 1
#endif
constexpr int N_PHASES = 8;
constexpr int N_LAUNCHES = MK_N_LAUNCHES;

constexpr int BATCH = 8, SEQ = 4096, D = 1024, M = BATCH * SEQ;
constexpr int NPROJ = 2304, FF = 2816, NGU = 2 * FF, NMOD = 6144;
constexpr int NHEAD = 8, HD = 64, BLK = 128;
constexpr int C_Q = 0, C_K = 512, C_V = 640, C_GB = 768, C_GC = 1280, C_XC = 1792;
constexpr float EPS = 1e-6f;

constexpr size_t MiB = 1u << 20;
constexpr size_t WS_CTL = 0, CTL_ZERO_BYTES = 1 * MiB;
constexpr size_t WS_MOD = 1 * MiB;
constexpr size_t WS_BIAS1 = WS_MOD + 256 * 1024;
constexpr size_t WS_BIAS2 = WS_MOD + 512 * 1024;
constexpr size_t WS_RSTD1 = WS_MOD + 768 * 1024;
constexpr size_t WS_SS2 = 2 * MiB;
constexpr size_t WS_W1T = 4 * MiB;
constexpr size_t WS_WOT = 9 * MiB;
constexpr size_t WS_WGUT = 11 * MiB;
constexpr size_t WS_WDT = 22 * MiB;
constexpr size_t WS_A = 28 * MiB;
constexpr size_t WS_PROJ = 92 * MiB;
constexpr size_t WS_MERGED = 236 * MiB;
constexpr size_t WS_HID = 92 * MiB;
constexpr size_t WS_END = 300 * MiB;
static_assert(WS_BIAS2 + (size_t)8 * NGU * 4 <= WS_RSTD1 && WS_RSTD1 + (size_t)M * 4 <= WS_SS2 && WS_SS2 + (size_t)M * 64 <= WS_W1T, "ws map 1");
static_assert(WS_W1T + (size_t)NPROJ * D * 2 <= WS_WOT && WS_WOT + (size_t)D * D * 2 <= WS_WGUT && WS_WGUT + (size_t)NGU * D * 2 <= WS_WDT && WS_WDT + (size_t)D * FF * 2 <= WS_A, "ws map 2");
static_assert(WS_A + (size_t)M * D * 2 <= WS_PROJ && WS_PROJ + (size_t)M * NPROJ * 2 <= WS_MERGED && WS_MERGED + (size_t)M * D * 2 <= WS_END && WS_HID + (size_t)M * FF * 2 <= WS_END, "ws map 3");
constexpr int CW_TMO = 0, CW_CODE = 1;
constexpr int CW_BAR = 4096;

constexpr int RING_OFF = 0, RING_BYTES = 131072;
constexpr int LDSCTL_OFF = RING_BYTES, MISC_OFF = LDSCTL_OFF + 320;
constexpr int MIX_OFF = RING_BYTES + 1024;
constexpr int LDS_BYTES = 147456;
static_assert(MISC_OFF + 128 <= MIX_OFF && MIX_OFF + 6144 <= LDS_BYTES, "LDS map");

__device__ const unsigned char T5_BUCKET[128] = {0,1,2,3,4,5,6,7,8,9,10,11,12,13,14,15,16,16,16,17,17,18,18,18,19,19,19,20,20,20,20,21,21,21,21,22,22,22,22,22,23,23,23,23,23,23,24,24,24,24,24,24,25,25,25,25,25,25,25,26,26,26,26,26,26,26,26,27,27,27,27,27,27,27,27,27,27,28,28,28,28,28,28,28,28,28,28,29,29,29,29,29,29,29,29,29,29,29,29,30,30,30,30,30,30,30,30,30,30,30,30,30,30,31,31,31,31,31,31,31,31,31,31,31,31,31,31,31};

struct Frame {
    LAS unsigned char* lds;
    volatile LAS unsigned* MISC;
    gu32* ctl;
    int tid, lane, wave;
    int vcu, G;
    const float *x, *c, *rel_bias, *w_ada, *b_ada, *g_norm1, *w_in, *sinks, *conv_w, *g_attn_out, *g_conv_out, *w_out, *g_norm2, *w_gu, *w_down, *g_final;
    float* out;
    float *mod, *bias1, *bias2, *rstd1, *ss2;
    bf16 *W1t, *Wot, *Wgut, *Wdt, *A, *PROJ, *MERGED, *HID;
};

__device__ __forceinline__ float wave_sum(float v) {
#pragma unroll
    for (int o = 1; o < 64; o <<= 1) v += __shfl_xor(v, o);
    return v;
}
__device__ __forceinline__ float bf_lo(unsigned w) { return __uint_as_float(w << 16); }
__device__ __forceinline__ float bf_hi(unsigned w) { return __uint_as_float(w & 0xffff0000u); }
__device__ __forceinline__ void unpack8(const v4u w, float* f) { f[0] = bf_lo(w.x); f[1] = bf_hi(w.x); f[2] = bf_lo(w.y); f[3] = bf_hi(w.y); f[4] = bf_lo(w.z); f[5] = bf_hi(w.z); f[6] = bf_lo(w.w); f[7] = bf_hi(w.w); }

__device__ __forceinline__ void p0_adaln(Frame& F, int chunk) {
    LAS float* sc = (LAS float*)(F.lds + RING_OFF);
    LAS float* red = (LAS float*)(F.lds + RING_OFF + 32768);
    for (int i = F.tid; i < BATCH * D; i += NWAVES * 64) { const float v = F.c[i]; sc[i] = v / (1.0f + expf(-v)); }
    __syncthreads();
    const int col = chunk * 64 + F.lane, kq = F.wave;
    float acc[BATCH];
#pragma unroll
    for (int b = 0; b < BATCH; ++b) acc[b] = 0.f;
    const float* wp = F.w_ada + (size_t)kq * NMOD + col;
#pragma unroll 8
    for (int i = 0; i < D / NWAVES; ++i) { const float w = wp[(size_t)i * NWAVES * NMOD]; const int k = kq + NWAVES * i;
#pragma unroll
        for (int b = 0; b < BATCH; ++b) acc[b] += sc[b * D + k] * w; }
#pragma unroll
    for (int b = 0; b < BATCH; ++b) red[(kq * BATCH + b) * 64 + F.lane] = acc[b];
    __syncthreads();
    { const int b = F.wave; float s = 0.f;
#pragma unroll
      for (int w = 0; w < NWAVES; ++w) s += red[(w * BATCH + b) * 64 + F.lane];
      F.mod[(size_t)b * NMOD + col] = s + F.b_ada[col]; }
    __syncthreads();
}
__device__ __forceinline__ void p0_transpose_item(const float* W, int K, int N, bf16* WT, int k0, int n0, int drow0, LAS float* scr, int lane) {
#pragma unroll 8
    for (int i = 0; i < 32; ++i) { const int kk = 2 * i + (lane >> 5); scr[kk * 33 + (lane & 31)] = W[(size_t)(k0 + kk) * N + n0 + (lane & 31)]; }
    LDS_WAIT(); asm volatile("" ::: "memory");
    const int c = lane & 7;
#pragma unroll
    for (int j = 0; j < 4; ++j) { const int n = (lane >> 3) + 8 * j; const LAS float* s = scr + (8 * c) * 33 + n;
        v4u o; o.x = pk2(s[0 * 33], s[1 * 33]); o.y = pk2(s[2 * 33], s[3 * 33]); o.z = pk2(s[4 * 33], s[5 * 33]); o.w = pk2(s[6 * 33], s[7 * 33]);
        *(GAS v4u*)(WT + (size_t)(drow0 + n) * K + k0 + 8 * c) = o; }
    LDS_WAIT(); asm volatile("" ::: "memory");
}
__device__ __forceinline__ void p0_prologue(Frame& F) {
    if ((int)blockIdx.x < NMOD / 64) p0_adaln(F, (int)blockIdx.x);
    LAS float* scr = (LAS float*)(F.lds + RING_OFF + F.wave * 16384);
    const int gw = F.vcu * NWAVES + F.wave, NGW = F.G * NWAVES;
    constexpr int I_IN = (D / 64) * (NPROJ / 32), I_OUT = (D / 64) * (D / 32), I_GU = (D / 64) * (NGU / 32), I_DN = (FF / 64) * (D / 32);
    constexpr int NITEMS = I_IN + I_OUT + I_GU + I_DN;
    for (int it = gw; it < NITEMS; it += NGW) {
        int r = it;
        if (r < I_IN) { const int nb = NPROJ / 32, kb = r / nb, n0 = 32 * (r % nb); p0_transpose_item(F.w_in, D, NPROJ, F.W1t, 64 * kb, n0, n0, scr, F.lane); continue; } r -= I_IN;
        if (r < I_OUT) { const int nb = D / 32, kb = r / nb, n0 = 32 * (r % nb); p0_transpose_item(F.w_out, D, D, F.Wot, 64 * kb, n0, n0, scr, F.lane); continue; } r -= I_OUT;
        if (r < I_GU) { const int nb = NGU / 32, kb = r / nb, n0 = 32 * (r % nb);
            const int drow0 = (n0 < FF) ? 256 * (n0 >> 7) + (n0 & 127) : 256 * ((n0 - FF) >> 7) + 128 + ((n0 - FF) & 127);
            p0_transpose_item(F.w_gu, D, NGU, F.Wgut, 64 * kb, n0, drow0, scr, F.lane); continue; } r -= I_GU;
        { const int nb = D / 32, kb = r / nb, n0 = 32 * (r % nb); p0_transpose_item(F.w_down, FF, D, F.Wdt, 64 * kb, n0, n0, scr, F.lane); }
    }
}

__device__ __forceinline__ void p1_norm(Frame& F) {
    LAS float* s1 = (LAS float*)(F.lds + RING_OFF); LAS float* s2 = s1 + BATCH * D;
    for (int i = F.tid; i < BATCH * D; i += NWAVES * 64) { const int b = i >> 10, k = i & 1023; s1[i] = F.mod[(size_t)b * NMOD + k]; s2[i] = F.mod[(size_t)b * NMOD + 3072 + k]; }
    __syncthreads();
    const int gw = F.vcu * NWAVES + F.wave, NGW = F.G * NWAVES;
    for (int m = gw; m < M; m += NGW) {
        const int b = m >> 12;
        const GAS f32x4* xr = (const GAS f32x4*)(F.x + (size_t)m * D) + F.lane;
        f32x4 v[4]; float s = 0.f;
#pragma unroll
        for (int j = 0; j < 4; ++j) { v[j] = xr[64 * j]; s += (v[j].x * v[j].x + v[j].y * v[j].y) + (v[j].z * v[j].z + v[j].w * v[j].w); }
        const float rstd = 1.0f / sqrtf(wave_sum(s) * (1.0f / D) + EPS);
        if (F.lane == 0) F.rstd1[m] = rstd;
        const GAS f32x4* gp = (const GAS f32x4*)F.g_norm1 + F.lane; const GAS f32x4* sp = (const GAS f32x4*)(F.mod + (size_t)b * NMOD + 1024) + F.lane;
        GAS unsigned long long* o8 = (GAS unsigned long long*)(F.A + (size_t)m * D) + F.lane;
#pragma unroll
        for (int j = 0; j < 4; ++j) { const f32x4 g = gp[64 * j] * (sp[64 * j] + 1.0f); const f32x4 w = v[j] * g;
            o8[64 * j] = (unsigned long long)pk2(w.x, w.y) | ((unsigned long long)pk2(w.z, w.w) << 32); }
    }
    for (int it = gw; it < NPROJ + NGU; it += NGW) {
        const bf16* wrow; LAS float* sh; float* dst; int ld;
        if (it < NPROJ) { wrow = F.W1t + (size_t)it * D; sh = s1; dst = F.bias1 + it; ld = NPROJ; } else { const int p = it - NPROJ; wrow = F.Wgut + (size_t)p * D; sh = s2; dst = F.bias2 + p; ld = NGU; }
        float wf[2][8];
#pragma unroll
        for (int j = 0; j < 2; ++j) { const v4u w = *(const GAS v4u*)(wrow + 512 * j + 8 * F.lane); unpack8(w, wf[j]); }
#pragma unroll
        for (int b = 0; b < BATCH; ++b) { float s = 0.f;
#pragma unroll
            for (int j = 0; j < 2; ++j)
#pragma unroll
                for (int e = 0; e < 8; ++e) s += wf[j][e] * sh[b * D + 512 * j + 8 * F.lane + e];
            s = wave_sum(s); if (F.lane == 0) dst[(size_t)b * ld] = s; }
    }
    __syncthreads();
}

__device__ __forceinline__ void p3_mixer(Frame& F) {
    LAS unsigned short* Kl = (LAS unsigned short*)(F.lds + RING_OFF);
    LAS unsigned short* Vl = Kl + 2 * 256 * 64;
    LAS float* btab = (LAS float*)(F.lds + MIX_OFF);
    LAS float* ssq = btab + 1024;
    for (int i = F.tid; i < 1024; i += NWAVES * 64) { const int h = i >> 7, dist = i & 127; btab[i] = F.rel_bias[(int)T5_BUCKET[dist] * NHEAD + h]; }
    for (int unit = (int)blockIdx.x; unit < BATCH * (SEQ / BLK); unit += F.G) {
        const int b = unit >> 5, n = unit & 31; const size_t R0 = (size_t)b * SEQ + (size_t)n * BLK;
        __syncthreads();
        for (int idx = F.tid; idx < 8192; idx += NWAVES * 64) {
            const int which = idx >> 12, kvh = (idx >> 11) & 1, j = (idx >> 3) & 255, ch = idx & 7;
            v4u val = (v4u){0u, 0u, 0u, 0u};
            if (n > 0 || j >= BLK) val = *(const GAS v4u*)(F.PROJ + (R0 + j - BLK) * NPROJ + C_K + which * 128 + kvh * HD + ch * 8);
            *(LAS v4u*)((which ? Vl : Kl) + (kvh * 256 + j) * HD + ch * 8) = val;
        }
        __syncthreads();
        const int h = F.wave, kvh = h >> 2; const float sink = F.sinks[h];
        for (int pass = 0; pass < 2; ++pass) {
            const int i = F.lane + 64 * pass; const size_t row = R0 + i;
            float q[HD], o[HD];
#pragma unroll
            for (int c8 = 0; c8 < 8; ++c8) { const v4u w = *(const GAS v4u*)(F.PROJ + row * NPROJ + C_Q + h * HD + c8 * 8); float t[8]; unpack8(w, t);
#pragma unroll
                for (int e = 0; e < 8; ++e) { q[c8 * 8 + e] = t[e] * 0.125f; o[c8 * 8 + e] = 0.f; } }
            float mrun = sink, l = 1.0f;
            int jlo = 64 * pass + 1; const int jhi = 64 * pass + 191; if (n == 0 && jlo < BLK) jlo = BLK;
            for (int j = jlo; j <= jhi; ++j) {
                const int dist = i + BLK - j; const bool valid = (dist >= 0) && (dist < BLK);
                const LAS unsigned short* kr = Kl + (kvh * 256 + j) * HD; const LAS unsigned short* vr = Vl + (kvh * 256 + j) * HD;
                float s = 0.f;
#pragma unroll
                for (int c8 = 0; c8 < 8; ++c8) { const v4u w = *(const LAS v4u*)(kr + c8 * 8); float t[8]; unpack8(w, t);
#pragma unroll
                    for (int e = 0; e < 8; ++e) s += q[c8 * 8 + e] * t[e]; }
                s += btab[h * 128 + (dist & 127)];
                s = valid ? s : -1e30f;
                const float mn = fmaxf(mrun, s); const float al = __expf(mrun - mn), p = __expf(s - mn);
                l = l * al + p; mrun = mn;
#pragma unroll
                for (int c8 = 0; c8 < 8; ++c8) { const v4u w = *(const LAS v4u*)(vr + c8 * 8); float t[8]; unpack8(w, t);
#pragma unroll
                    for (int e = 0; e < 8; ++e) o[c8 * 8 + e] = o[c8 * 8 + e] * al + p * t[e]; }
            }
            const float inv = 1.0f / l; float ss = 0.f;
#pragma unroll
            for (int d = 0; d < HD; ++d) { o[d] *= inv; ss += o[d] * o[d]; }
            ssq[h * 64 + F.lane] = ss;
            __syncthreads();
            float tot = 0.f;
#pragma unroll
            for (int hh = 0; hh < NHEAD; ++hh) tot += ssq[hh * 64 + F.lane];
            const float rstd = 1.0f / sqrtf(tot * (1.0f / 512.0f) + EPS);
#pragma unroll
            for (int c8 = 0; c8 < 8; ++c8) { const f32x4 g0 = *(const GAS f32x4*)(F.g_attn_out + h * HD + c8 * 8), g1 = *(const GAS f32x4*)(F.g_attn_out + h * HD + c8 * 8 + 4);
                v4u w; w.x = pk2(o[c8 * 8 + 0] * rstd * g0.x, o[c8 * 8 + 1] * rstd * g0.y); w.y = pk2(o[c8 * 8 + 2] * rstd * g0.z, o[c8 * 8 + 3] * rstd * g0.w);
                w.z = pk2(o[c8 * 8 + 4] * rstd * g1.x, o[c8 * 8 + 5] * rstd * g1.y); w.w = pk2(o[c8 * 8 + 6] * rstd * g1.z, o[c8 * 8 + 7] * rstd * g1.w);
                *(GAS v4u*)(F.MERGED + row * D + h * HD + c8 * 8) = w; }
            __syncthreads();
        }
        {
            const int c0 = 8 * F.lane, tt0 = 16 * F.wave;
            float w0[8], w1[8], w2[8], gco[8], u1[8], u2[8];
#pragma unroll
            for (int e = 0; e < 8; ++e) { w0[e] = F.conv_w[c0 + e]; w1[e] = F.conv_w[512 + c0 + e]; w2[e] = F.conv_w[1024 + c0 + e]; gco[e] = F.g_conv_out[c0 + e]; u1[e] = 0.f; u2[e] = 0.f; }
            for (int pre = 2; pre >= 1; --pre) {
                const int pos = n * BLK + tt0 - pre;
                if (pos >= 0) { const size_t r = R0 + tt0 - pre; const v4u cw = *(const GAS v4u*)(F.PROJ + r * NPROJ + C_GC + c0), xw = *(const GAS v4u*)(F.PROJ + r * NPROJ + C_XC + c0);
                    float cf[8], xf[8]; unpack8(cw, cf); unpack8(xw, xf);
#pragma unroll
                    for (int e = 0; e < 8; ++e) { if (pre == 2) u2[e] = cf[e] * xf[e]; else u1[e] = cf[e] * xf[e]; } }
            }
            for (int i = 0; i < 16; ++i) {
                const size_t r = R0 + tt0 + i;
                const v4u bw = *(const GAS v4u*)(F.PROJ + r * NPROJ + C_GB + c0), cw = *(const GAS v4u*)(F.PROJ + r * NPROJ + C_GC + c0), xw = *(const GAS v4u*)(F.PROJ + r * NPROJ + C_XC + c0);
                float bfv[8], cf[8], xf[8], y[8]; unpack8(bw, bfv); unpack8(cw, cf); unpack8(xw, xf);
                float ss = 0.f;
#pragma unroll
                for (int e = 0; e < 8; ++e) { const float u0 = cf[e] * xf[e]; y[e] = bfv[e] * (w0[e] * u2[e] + w1[e] * u1[e] + w2[e] * u0); ss += y[e] * y[e]; u2[e] = u1[e]; u1[e] = u0; }
                const float rstd = 1.0f / sqrtf(wave_sum(ss) * (1.0f / 512.0f) + EPS);
                v4u w; w.x = pk2(y[0] * rstd * gco[0], y[1] * rstd * gco[1]); w.y = pk2(y[2] * rstd * gco[2], y[3] * rstd * gco[3]);
                w.z = pk2(y[4] * rstd * gco[4], y[5] * rstd * gco[5]); w.w = pk2(y[6] * rstd * gco[6], y[7] * rstd * gco[7]);
                *(GAS v4u*)(F.MERGED + r * D + 512 + c0) = w;
            }
        }
    }
    __syncthreads();
}

__device__ __forceinline__ void p7_final(Frame& F) {
    const int gw = F.vcu * NWAVES + F.wave, NGW = F.G * NWAVES;
    for (int m = gw; m < M; m += NGW) {
        GAS f32x4* xr = (GAS f32x4*)(F.out + (size_t)m * D) + F.lane;
        f32x4 v[4]; float s = 0.f;
#pragma unroll
        for (int j = 0; j < 4; ++j) { v[j] = xr[64 * j]; s += (v[j].x * v[j].x + v[j].y * v[j].y) + (v[j].z * v[j].z + v[j].w * v[j].w); }
        const float rstd = 1.0f / sqrtf(wave_sum(s) * (1.0f / D) + EPS);
        const GAS f32x4* gp = (const GAS f32x4*)F.g_final + F.lane;
#pragma unroll
        for (int j = 0; j < 4; ++j) xr[64 * j] = v[j] * rstd * gp[64 * j];
    }
}

struct Args { const float* in[16]; float* out; unsigned char* ws; int ph_lo, ph_hi; };
__global__ void __launch_bounds__(NWAVES * 64, 2) hymba_fwd(Args args) {
    extern __shared__ __attribute__((aligned(16))) unsigned char lds[];
    Frame F;
    F.lds = (LAS unsigned char*)lds;
    F.MISC = (volatile LAS unsigned*)(F.lds + MISC_OFF);
    F.tid = threadIdx.x; F.lane = F.tid & 63; F.wave = __builtin_amdgcn_readfirstlane(F.tid >> 6);
    F.G = gridDim.x; { const int bx = blockIdx.x; F.vcu = (F.G % 8 == 0) ? (bx % 8) * (F.G / 8) + bx / 8 : bx; }
    unsigned char* ws = args.ws;
    F.ctl = (gu32*)(ws + WS_CTL);
    F.x = args.in[0]; F.c = args.in[1]; F.rel_bias = args.in[2]; F.w_ada = args.in[3]; F.b_ada = args.in[4]; F.g_norm1 = args.in[5]; F.w_in = args.in[6]; F.sinks = args.in[7];
    F.conv_w = args.in[8]; F.g_attn_out = args.in[9]; F.g_conv_out = args.in[10]; F.w_out = args.in[11]; F.g_norm2 = args.in[12]; F.w_gu = args.in[13]; F.w_down = args.in[14]; F.g_final = args.in[15];
    F.out = args.out;
    F.mod = (float*)(ws + WS_MOD); F.bias1 = (float*)(ws + WS_BIAS1); F.bias2 = (float*)(ws + WS_BIAS2); F.rstd1 = (float*)(ws + WS_RSTD1); F.ss2 = (float*)(ws + WS_SS2);
    F.W1t = (bf16*)(ws + WS_W1T); F.Wot = (bf16*)(ws + WS_WOT); F.Wgut = (bf16*)(ws + WS_WGUT); F.Wdt = (bf16*)(ws + WS_WDT);
    F.A = (bf16*)(ws + WS_A); F.PROJ = (bf16*)(ws + WS_PROJ); F.MERGED = (bf16*)(ws + WS_MERGED); F.HID = (bf16*)(ws + WS_HID);
    for (int u = F.tid; u < (MIX_OFF - LDSCTL_OFF) / 4; u += NWAVES * 64) ((LAS unsigned*)(F.lds + LDSCTL_OFF))[u] = 0u;
    __syncthreads();
    XcdBarrier bar; bar.bar = (unsigned*)(F.ctl + CW_BAR); bar.x = 0; bar.st = nullptr;
    if (N_LAUNCHES == 1) bar = xcd_barrier_post((unsigned*)(F.ctl + CW_BAR), F.MISC + 8);
#define GRID_BAR() do { if (N_LAUNCHES == 1) xcd_barrier(bar); } while (0)
    const int lo = args.ph_lo, hi = args.ph_hi;
#define IN(k) (lo <= (k) && (k) < hi)
#define BOTH(k) (IN(k) && IN((k) + 1))

    if (IN(0)) { p0_prologue(F); if (BOTH(0)) GRID_BAR(); }
    if (IN(1)) { p1_norm(F); if (BOTH(1)) GRID_BAR(); }
    if (IN(2)) {
        pg8::Gemm g{F.A, F.W1t, M, NPROJ, D}; pg8::StaticOrder S; S.init(M, NPROJ, F.G, (int)blockIdx.x);
        pg8::EpiProj E{F.PROJ, F.rstd1, F.bias1};
        pg8::gemm_phase<pg8::EpiProj, pg8::StaticOrder, true, true>(F.lds + RING_OFF, g, S, E);
        if (BOTH(2)) GRID_BAR();
    }
    if (IN(3)) { p3_mixer(F); if (BOTH(3)) GRID_BAR(); }
    if (IN(4)) {
        pg8::Gemm g{F.MERGED, F.Wot, M, D, D}; pg8::StaticOrder S; S.init(M, D, F.G, (int)blockIdx.x);
        pg8::EpiOut E{F.x, F.out, F.A, F.mod, F.g_norm2, F.ss2};
        pg8::gemm_phase<pg8::EpiOut, pg8::StaticOrder, true, true>(F.lds + RING_OFF, g, S, E);
        if (BOTH(4)) GRID_BAR();
    }
    if (IN(5)) {
        pg8::Gemm g{F.A, F.Wgut, M, NGU, D}; pg8::StaticOrder S; S.init(M, NGU, F.G, (int)blockIdx.x);
        pg8::EpiGU E{F.HID, F.ss2, F.bias2};
        pg8::gemm_phase<pg8::EpiGU, pg8::StaticOrder, true, true>(F.lds + RING_OFF, g, S, E);
        if (BOTH(5)) GRID_BAR();
    }
    if (IN(6)) {
        pg8::Gemm g{F.HID, F.Wdt, M, D, FF}; pg8::StaticOrder S; S.init(M, D, F.G, (int)blockIdx.x);
        pg8::EpiDown E{F.out, F.mod};
        pg8::gemm_phase<pg8::EpiDown, pg8::StaticOrder, true, true>(F.lds + RING_OFF, g, S, E);
        if (BOTH(6)) GRID_BAR();
    }
    if (IN(7)) { p7_final(F); }
#undef IN
#undef BOTH
}

extern "C" void kernel_launch(void* const* d_in, const int* in_sizes, int n_in, void* d_out, int out_size, void* d_ws, size_t ws_size, hipStream_t stream) {
    static int grid = 0;
    if (grid == 0) {
        if (n_in != 16 || in_sizes[0] != M * D || out_size != M * D || ws_size < WS_END) { fprintf(stderr, "kernel_launch: unexpected shapes (n_in %d, in0 %d, out %d, ws %zu); nothing launched\n", n_in, n_in > 0 ? in_sizes[0] : -1, out_size, ws_size); grid = -1; return; }
        int dev = 0, cus = 0, per_cu = 0;
        if (hipGetDevice(&dev) != hipSuccess || hipDeviceGetAttribute(&cus, hipDeviceAttributeMultiprocessorCount, dev) != hipSuccess) { grid = -1; return; }
        if (hipFuncSetAttribute((const void*)hymba_fwd, hipFuncAttributeMaxDynamicSharedMemorySize, LDS_BYTES) != hipSuccess) { fprintf(stderr, "kernel_launch: hipFuncSetAttribute failed\n"); grid = -1; return; }
        if (hipOccupancyMaxActiveBlocksPerMultiprocessor(&per_cu, (const void*)hymba_fwd, NWAVES * 64, LDS_BYTES) != hipSuccess || per_cu < 1) { fprintf(stderr, "kernel_launch: occupancy query says %d blocks per CU\n", per_cu); }
        (void)hipGetLastError();
        grid = cus;
    }
    if (grid < 0) return;
    if (hipMemsetAsync((char*)d_ws + WS_CTL, 0, CTL_ZERO_BYTES, stream) != hipSuccess) return;
    Args a{};
    for (int i = 0; i < 16; ++i) a.in[i] = (const float*)d_in[i];
    a.out = (float*)d_out; a.ws = (unsigned char*)d_ws;
    if (N_LAUNCHES == 1) { a.ph_lo = 0; a.ph_hi = N_PHASES; hipLaunchKernelGGL(hymba_fwd, dim3(grid), dim3(NWAVES * 64), LDS_BYTES, stream, a); }
    else for (int li = 0; li < N_PHASES; ++li) { a.ph_lo = li; a.ph_hi = li + 1; hipLaunchKernelGGL(hymba_fwd, dim3(grid), dim3(NWAVES * 64), LDS_BYTES, stream, a); }
}
```

```cpp
#include <hip/hip_runtime.h>
#include <cstdio>
#include <cstdint>
#define MK_N_LAUNCHES 1
namespace pg8 {
#define PG8_LAS __attribute__((address_space(3)))
typedef unsigned short bf16_t;
typedef short bf16x8 __attribute__((ext_vector_type(8)));
typedef float f32x4 __attribute__((ext_vector_type(4)));
typedef unsigned u32x4 __attribute__((ext_vector_type(4)));
constexpr int BM = 256, BK = 64, HALF = 128, HTB = HALF * BK * 2  , STAGE_BYTES = 8 * HTB, NXCD = 8, WGM = 8;

__host__ __device__ __forceinline__ int lds_byte(int r, int c) { const int st = (r >> 4) * 2 + (c >> 5), rr = r & 15, cc = c & 31, ob = rr * 64 + cc * 2; return st * 1024 + (ob ^ (((ob >> 9) & 1) << 5)); }
__host__ __device__ __forceinline__ void stage_rc(int b, int& R, int& C) { const int st = b / 1024, sb = b % 1024, swz = sb ^ (((sb >> 9) & 1) << 5); R = (st >> 1) * 16 + swz / 64; C = (st & 1) * 32 + (swz % 64) / 2; }
__host__ __device__ __forceinline__ int perm32(int rho) { const int n = rho >> 4, i = rho & 15; return 8 * (i >> 2) + 4 * n + (i & 3); }

struct Unit { int pm, pn; };
struct Gemm { const bf16_t* A; const bf16_t* Bt; int M, N, K; };

struct StaticOrder {
    int nM, nN, nwg, G, c;
    __host__ __device__ void init(int M, int N, int G_, int c_) { nM = M / BM; nN = N / BM; nwg = nM * nN; G = G_; c = c_; }
    __host__ __device__ bool next(int i, Unit& u) const {
        const long L = (long)i * G + c; if (L >= nwg) return false;
        int wgid = (int)L; { const int q = nwg / NXCD, r = nwg % NXCD, xcd = wgid % NXCD, off = wgid / NXCD; wgid = (xcd < r ? xcd * (q + 1) : r * (q + 1) + (xcd - r) * q) + off; }
        const int nig = WGM * nN, gid = wgid / nig, fm = gid * WGM, gsz = (nM - fm) < WGM ? (nM - fm) : WGM;
        u.pm = fm + ((wgid % nig) % gsz); u.pn = (wgid % nig) / gsz; return true;
    }
    __device__ __forceinline__ void a_ready(const Unit&) const {}
    __device__ __forceinline__ void done(const Unit&) const {}
};

__device__ __forceinline__ unsigned cvt_pk_bf16(float lo, float hi) { unsigned r; asm volatile("v_cvt_pk_bf16_f32 %0, %1, %2" : "=v"(r) : "v"(lo), "v"(hi)); return r; }
typedef float f32x2 __attribute__((ext_vector_type(2)));
template <class Epi, class Sched, bool ALIGN_EPI = false, bool SP2 = false>
__device__ __forceinline__ void gemm_phase(PG8_LAS unsigned char* lds, const Gemm g, const Sched& S, const Epi& E) {
    const int tid = threadIdx.x, wid = __builtin_amdgcn_readfirstlane(tid >> 6), lane = tid & 63, wr = wid >> 2, wc = wid & 3, fr = lane & 15, fq = lane >> 4;
    const int K = g.K, nt = K / BK;
    unsigned voffA[2], voffB[2];
#pragma unroll
    for (int i = 0; i < 2; ++i) { int R, C; stage_rc(tid * 16 + i * 8192, R, C); const int Rb = Epi::PERM ? ((R & ~31) + perm32(R & 31)) : R;
        voffA[i] = (unsigned)(R * K + C) * 2u; voffB[i] = (unsigned)(Rb * K + C) * 2u; }
    const size_t kstep = (size_t)(BK * 2);
    const size_t hstep = (size_t)HALF * K * 2;
    const size_t tstep = 2 * hstep;
    const unsigned ldsw = (unsigned)wid * 1024u;
    const int aoff = lds_byte(wr * 64 + fr, fq * 8), boff = lds_byte(wc * 32 + fr, fq * 8);
#define PG8_SA(b, h) (((b) * 2 + (h)) * HTB)
#define PG8_SB(b, h) ((4 + (b) * 2 + (h)) * HTB)
#define PG8_STAGE(bufoff, gbase, voff) do { _Pragma("unroll") for (int _i = 0; _i < 2; ++_i) \
        __builtin_amdgcn_global_load_lds((const unsigned*)((const char*)(gbase) + (voff)[_i]), (PG8_LAS unsigned*)(lds + (bufoff) + ldsw + _i * 8192), 16, 0, 0); } while (0)
#define PG8_LDA(dst, b, h) do { _Pragma("unroll") for (int m = 0; m < 4; ++m) _Pragma("unroll") for (int k = 0; k < 2; ++k) dst[m][k] = *(const PG8_LAS bf16x8*)(lds + PG8_SA(b, h) + aoff + m * 2048 + k * 1024); } while (0)
#define PG8_LDB(dst, b, h) do { _Pragma("unroll") for (int n = 0; n < 2; ++n) _Pragma("unroll") for (int k = 0; k < 2; ++k) dst[n][k] = *(const PG8_LAS bf16x8*)(lds + PG8_SB(b, h) + boff + n * 2048 + k * 1024); } while (0)
#define PG8_MMA(ai, bj, At, Bt) do { __builtin_amdgcn_s_setprio(1); _Pragma("unroll") for (int m = 0; m < 4; ++m) _Pragma("unroll") for (int n = 0; n < 2; ++n) _Pragma("unroll") for (int k = 0; k < 2; ++k) \
        acc[ai][bj][m][n] = __builtin_amdgcn_mfma_f32_16x16x32_bf16(Bt[n][k], At[m][k], acc[ai][bj][m][n], 0, 0, 0); __builtin_amdgcn_s_setprio(0); } while (0)
#define PG8_WAIT_V(n) asm volatile("s_waitcnt vmcnt(" #n ")" ::: "memory")
#define PG8_WAIT_L(n) asm volatile("s_waitcnt lgkmcnt(" #n ")" ::: "memory")
#define PG8_BAR __builtin_amdgcn_s_barrier()
#define PG8_SCHED __builtin_amdgcn_sched_barrier(0)
    Unit cur, nxt; int ui = 0;
    if (!S.next(0, cur)) return;
    f32x4 acc[2][2][4][2];
#pragma unroll
    for (int a = 0; a < 2; ++a)
#pragma unroll
        for (int b = 0; b < 2; ++b)
#pragma unroll
            for (int m = 0; m < 4; ++m)
#pragma unroll
                for (int n = 0; n < 2; ++n) acc[a][b][m][n] = (f32x4){0.f, 0.f, 0.f, 0.f};
    bf16x8 At[4][2], B0[2][2], B1[2][2];
    const char* cA = (const char*)g.A + (size_t)cur.pm * tstep; const char* cB = (const char*)g.Bt + (size_t)cur.pn * tstep;
    S.a_ready(cur);
    if constexpr (SP2) {
        PG8_STAGE(PG8_SB(0, 0), cB, voffB); PG8_STAGE(PG8_SB(0, 1), cB + hstep, voffB); PG8_STAGE(PG8_SA(0, 0), cA, voffA); PG8_STAGE(PG8_SA(0, 1), cA + hstep, voffA);
        if (wr == 1) PG8_BAR;
        PG8_WAIT_V(2); PG8_BAR;
        PG8_STAGE(PG8_SB(1, 0), cB + kstep, voffB); PG8_STAGE(PG8_SA(1, 0), cA + kstep, voffA); PG8_STAGE(PG8_SB(1, 1), cB + hstep + kstep, voffB);
        PG8_WAIT_V(6); PG8_BAR;
    } else {
        PG8_STAGE(PG8_SB(0, 0), cB, voffB); PG8_STAGE(PG8_SA(0, 0), cA, voffA); PG8_STAGE(PG8_SB(0, 1), cB + hstep, voffB); PG8_STAGE(PG8_SA(0, 1), cA + hstep, voffA);
        if (wr == 1) PG8_BAR;
        PG8_WAIT_V(4); PG8_BAR;
        PG8_STAGE(PG8_SB(1, 0), cB + kstep, voffB); PG8_STAGE(PG8_SA(1, 0), cA + kstep, voffA); PG8_STAGE(PG8_SB(1, 1), cB + hstep + kstep, voffB);
        PG8_WAIT_V(6); PG8_BAR;
    }
    for (;;) {
        const bool has_next = S.next(ui + 1, nxt);
        const char* nA = has_next ? (const char*)g.A + (size_t)nxt.pm * tstep : cA; const char* nB = has_next ? (const char*)g.Bt + (size_t)nxt.pn * tstep : cB;
        for (int t = 0; t < nt; t += 2) {
            const bool last = (t == nt - 2);
            const char* a1 = cA + (size_t)(t + 1) * kstep;
            const char* a2 = last ? nA : cA + (size_t)(t + 2) * kstep; const char* b2 = last ? nB : cB + (size_t)(t + 2) * kstep;
            const char* a3 = a2 + kstep; const char* b3 = b2 + kstep;
            if (last && has_next) S.a_ready(nxt);
            if constexpr (SP2) {
            PG8_LDB(B0, 0, 0); PG8_LDB(B1, 0, 1); PG8_SCHED; PG8_LDA(At, 0, 0); PG8_STAGE(PG8_SA(1, 1), a1 + hstep, voffA);
            PG8_WAIT_V(8); PG8_WAIT_L(0); PG8_BAR; PG8_MMA(0, 0, At, B0); PG8_MMA(0, 1, At, B1); PG8_BAR; PG8_SCHED;
            PG8_LDA(At, 0, 1); PG8_STAGE(PG8_SB(0, 0), b2, voffB); PG8_STAGE(PG8_SB(0, 1), b2 + hstep, voffB); PG8_STAGE(PG8_SA(0, 0), a2, voffA);
            PG8_WAIT_V(8); PG8_WAIT_L(0); PG8_BAR; PG8_MMA(1, 0, At, B0); PG8_MMA(1, 1, At, B1); PG8_BAR; PG8_SCHED;
            PG8_LDB(B0, 1, 0); PG8_LDB(B1, 1, 1); PG8_SCHED; PG8_LDA(At, 1, 0); PG8_STAGE(PG8_SA(0, 1), a2 + hstep, voffA);
            PG8_WAIT_V(8); PG8_WAIT_L(0); PG8_BAR; PG8_MMA(0, 0, At, B0); PG8_MMA(0, 1, At, B1); PG8_BAR; PG8_SCHED;
            PG8_LDA(At, 1, 1); PG8_STAGE(PG8_SB(1, 0), b3, voffB); PG8_STAGE(PG8_SB(1, 1), b3 + hstep, voffB); PG8_STAGE(PG8_SA(1, 0), a3, voffA);
            PG8_WAIT_V(8); PG8_WAIT_L(0); PG8_BAR; PG8_MMA(1, 0, At, B0); PG8_MMA(1, 1, At, B1); PG8_BAR; PG8_SCHED;
            } else {
            PG8_LDB(B0, 0, 0); PG8_SCHED; PG8_LDA(At, 0, 0); PG8_STAGE(PG8_SA(1, 1), a1 + hstep, voffA);
            PG8_WAIT_L(8); PG8_BAR; PG8_WAIT_L(0); PG8_MMA(0, 0, At, B0); PG8_BAR; PG8_SCHED;
            PG8_LDB(B1, 0, 1); PG8_STAGE(PG8_SB(0, 0), b2, voffB);
            PG8_BAR; PG8_WAIT_L(0); PG8_MMA(0, 1, At, B1); PG8_BAR;
            PG8_LDA(At, 0, 1); PG8_STAGE(PG8_SA(0, 0), a2, voffA);
            PG8_BAR; PG8_WAIT_L(0); PG8_MMA(1, 0, At, B0); PG8_BAR; PG8_SCHED;
            PG8_STAGE(PG8_SB(0, 1), b2 + hstep, voffB);
            PG8_WAIT_V(6); PG8_BAR; PG8_MMA(1, 1, At, B1); PG8_BAR;
            PG8_LDB(B0, 1, 0); PG8_SCHED; PG8_LDA(At, 1, 0); PG8_STAGE(PG8_SA(0, 1), a2 + hstep, voffA);
            PG8_WAIT_L(8); PG8_BAR; PG8_WAIT_L(0); PG8_MMA(0, 0, At, B0); PG8_BAR; PG8_SCHED;
            PG8_LDB(B1, 1, 1); PG8_STAGE(PG8_SB(1, 0), b3, voffB);
            PG8_BAR; PG8_WAIT_L(0); PG8_MMA(0, 1, At, B1); PG8_BAR;
            PG8_LDA(At, 1, 1); PG8_STAGE(PG8_SA(1, 0), a3, voffA);
            PG8_BAR; PG8_WAIT_L(0); PG8_MMA(1, 0, At, B0); PG8_BAR; PG8_SCHED;
            PG8_STAGE(PG8_SB(1, 1), b3 + hstep, voffB);
            PG8_WAIT_V(6); PG8_BAR; PG8_MMA(1, 1, At, B1); PG8_BAR;
            }
        }
        if constexpr (ALIGN_EPI) { if (wr == 0) PG8_BAR; }
        if constexpr (!Epi::AFTER_DRAIN) { E(acc, cur, wr, wc, fr, fq); S.done(cur); }
        if (!has_next) break;
#pragma unroll
        for (int a = 0; a < 2; ++a)
#pragma unroll
            for (int b = 0; b < 2; ++b)
#pragma unroll
                for (int m = 0; m < 4; ++m)
#pragma unroll
                    for (int n = 0; n < 2; ++n) acc[a][b][m][n] = (f32x4){0.f, 0.f, 0.f, 0.f};
        cur = nxt; cA = nA; cB = nB; ++ui;
        if constexpr (ALIGN_EPI) { if (wr == 1) PG8_BAR; }
    }
    PG8_WAIT_V(0);
    if constexpr (!ALIGN_EPI) { if (wr == 0) PG8_BAR; }
    PG8_BAR;
    if constexpr (Epi::AFTER_DRAIN) { E.fused(acc, cur, wr, wc, fr, fq, lds, wid, lane); S.done(cur); }
#undef PG8_SA
#undef PG8_SB
#undef PG8_STAGE
#undef PG8_LDA
#undef PG8_LDB
#undef PG8_MMA
#undef PG8_WAIT_V
#undef PG8_WAIT_L
#undef PG8_BAR
#undef PG8_SCHED
}
}

namespace pg8 {
typedef unsigned u32x2 __attribute__((ext_vector_type(2)));
constexpr int E_SEQ = 4096, E_D = 1024, E_NPROJ = 2304, E_FF = 2816, E_NGU = 5632, E_NMOD = 6144;
constexpr float E_EPS = 1e-6f;

struct EpiProj {
    static constexpr bool PERM = true, AFTER_DRAIN = false;
    bf16_t* O; const float* rstd; const float* bias;
    __device__ __forceinline__ void operator()(const f32x4 (&acc)[2][2][4][2], const Unit& u, int wr, int wc, int fr, int fq) const {
        const int row0 = u.pm * BM + wr * 64 + fr, col0 = u.pn * BM + wc * 32 + 8 * fq;
        const int b = (u.pm * BM) / E_SEQ;
        const float* bp = bias + (size_t)b * E_NPROJ + col0;
        f32x4 bv[2][2];
#pragma unroll
        for (int bj = 0; bj < 2; ++bj)
#pragma unroll
            for (int n = 0; n < 2; ++n) bv[bj][n] = *(const f32x4*)(bp + bj * HALF + 4 * n);
#pragma unroll
        for (int ai = 0; ai < 2; ++ai)
#pragma unroll
            for (int m = 0; m < 4; ++m) { const int row = row0 + ai * HALF + m * 16; const float rs = rstd[row]; bf16_t* rowp = O + (size_t)row * E_NPROJ + col0;
#pragma unroll
                for (int bj = 0; bj < 2; ++bj) { const f32x4 v0 = acc[ai][bj][m][0] * rs + bv[bj][0], v1 = acc[ai][bj][m][1] * rs + bv[bj][1];
                    u32x4 w; w.x = cvt_pk_bf16(v0[0], v0[1]); w.y = cvt_pk_bf16(v0[2], v0[3]); w.z = cvt_pk_bf16(v1[0], v1[1]); w.w = cvt_pk_bf16(v1[2], v1[3]);
                    *(u32x4*)(rowp + bj * HALF) = w; } }
    }
};

struct EpiOut {
    static constexpr bool PERM = false, AFTER_DRAIN = false;
    const float* x; float* x1; bf16_t* a2; const float* mod; const float* gn2; float* ss;
    __device__ __forceinline__ void operator()(const f32x4 (&acc)[2][2][4][2], const Unit& u, int wr, int wc, int fr, int fq) const {
        const int row0 = u.pm * BM + wr * 64 + fr, col0 = u.pn * BM + wc * 32 + 4 * fq;
        const int b = (u.pm * BM) / E_SEQ;
        const float* g1p = mod + (size_t)b * E_NMOD + 2048 + col0; const float* sc2p = mod + (size_t)b * E_NMOD + 4096 + col0; const float* gnp = gn2 + col0;
        f32x4 g1v[2][2], gm[2][2];
#pragma unroll
        for (int bj = 0; bj < 2; ++bj)
#pragma unroll
            for (int n = 0; n < 2; ++n) { const int o = bj * HALF + n * 16; g1v[bj][n] = *(const f32x4*)(g1p + o); gm[bj][n] = *(const f32x4*)(gnp + o) * (*(const f32x4*)(sc2p + o) + 1.0f); }
#pragma unroll
        for (int ai = 0; ai < 2; ++ai)
#pragma unroll
            for (int m = 0; m < 4; ++m) { const int row = row0 + ai * HALF + m * 16; const size_t off = (size_t)row * E_D + col0; float s = 0.f;
#pragma unroll
                for (int bj = 0; bj < 2; ++bj)
#pragma unroll
                    for (int n = 0; n < 2; ++n) { const int o = bj * HALF + n * 16; const f32x4 xv = *(const f32x4*)(x + off + o); const f32x4 v = xv + g1v[bj][n] * acc[ai][bj][m][n];
                        *(f32x4*)(x1 + off + o) = v; s += (v[0] * v[0] + v[1] * v[1]) + (v[2] * v[2] + v[3] * v[3]);
                        const f32x4 w = v * gm[bj][n]; u32x2 p; p.x = cvt_pk_bf16(w[0], w[1]); p.y = cvt_pk_bf16(w[2], w[3]); *(u32x2*)(a2 + off + o) = p; }
                s += __shfl_xor(s, 16); s += __shfl_xor(s, 32);
                if (fq == 0) ss[(size_t)row * 16 + u.pn * 4 + wc] = s; }
    }
};

struct EpiGU {
    static constexpr bool PERM = true, AFTER_DRAIN = false;
    bf16_t* H; const float* ss; const float* bias;
    __device__ __forceinline__ void operator()(const f32x4 (&acc)[2][2][4][2], const Unit& u, int wr, int wc, int fr, int fq) const {
        const int row0 = u.pm * BM + wr * 64 + fr, colt = wc * 32 + 8 * fq;
        const int b = (u.pm * BM) / E_SEQ;
        const float* bp = bias + (size_t)b * E_NGU + u.pn * BM + colt;
        f32x4 bg[2], bu[2];
#pragma unroll
        for (int n = 0; n < 2; ++n) { bg[n] = *(const f32x4*)(bp + 4 * n); bu[n] = *(const f32x4*)(bp + HALF + 4 * n); }
#pragma unroll
        for (int ai = 0; ai < 2; ++ai)
#pragma unroll
            for (int m = 0; m < 4; ++m) { const int row = row0 + ai * HALF + m * 16;
                const f32x4* sp = (const f32x4*)(ss + (size_t)row * 16); const f32x4 s0 = sp[0], s1 = sp[1], s2 = sp[2], s3 = sp[3];
                const float tot = ((s0[0] + s0[1]) + (s0[2] + s0[3])) + ((s1[0] + s1[1]) + (s1[2] + s1[3])) + ((s2[0] + s2[1]) + (s2[2] + s2[3])) + ((s3[0] + s3[1]) + (s3[2] + s3[3]));
                const float rs = 1.0f / sqrtf(tot * (1.0f / E_D) + E_EPS);
                float hv[8];
#pragma unroll
                for (int n = 0; n < 2; ++n) { const f32x4 g = acc[ai][0][m][n] * rs + bg[n], up = acc[ai][1][m][n] * rs + bu[n];
#pragma unroll
                    for (int e = 0; e < 4; ++e) { const float sg = g[e] * __builtin_amdgcn_rcpf(1.0f + __builtin_amdgcn_exp2f(g[e] * -1.4426950408889634f)); hv[4 * n + e] = sg * up[e]; } }
                u32x4 w; w.x = cvt_pk_bf16(hv[0], hv[1]); w.y = cvt_pk_bf16(hv[2], hv[3]); w.z = cvt_pk_bf16(hv[4], hv[5]); w.w = cvt_pk_bf16(hv[6], hv[7]);
                *(u32x4*)(H + (size_t)row * E_FF + u.pn * HALF + colt) = w; }
    }
};

struct EpiDown {
    static constexpr bool PERM = false, AFTER_DRAIN = false;
    float* x1; const float* mod;
    __device__ __forceinline__ void operator()(const f32x4 (&acc)[2][2][4][2], const Unit& u, int wr, int wc, int fr, int fq) const {
        const int row0 = u.pm * BM + wr * 64 + fr, col0 = u.pn * BM + wc * 32 + 4 * fq;
        const int b = (u.pm * BM) / E_SEQ;
        const float* g2p = mod + (size_t)b * E_NMOD + 5120 + col0;
        f32x4 g2v[2][2];
#pragma unroll
        for (int bj = 0; bj < 2; ++bj)
#pragma unroll
            for (int n = 0; n < 2; ++n) g2v[bj][n] = *(const f32x4*)(g2p + bj * HALF + n * 16);
#pragma unroll
        for (int ai = 0; ai < 2; ++ai)
#pragma unroll
            for (int m = 0; m < 4; ++m) { const int row = row0 + ai * HALF + m * 16; const size_t off = (size_t)row * E_D + col0;
#pragma unroll
                for (int bj = 0; bj < 2; ++bj)
#pragma unroll
                    for (int n = 0; n < 2; ++n) { const int o = bj * HALF + n * 16; const f32x4 xv = *(const f32x4*)(x1 + off + o); *(f32x4*)(x1 + off + o) = xv + g2v[bj][n] * acc[ai][bj][m][n]; } }
    }
};
}
#define GAS __attribute__((address_space(1)))
#define LAS __attribute__((address_space(3)))
typedef unsigned short bf16;
typedef unsigned v4u __attribute__((ext_vector_type(4)));
typedef float f32x4 __attribute__((ext_vector_type(4)));
typedef short bf16x8 __attribute__((ext_vector_type(8)));
typedef GAS unsigned gu32;
typedef GAS unsigned long long gu64;
#define RLX_AGENT __ATOMIC_RELAXED, __HIP_MEMORY_SCOPE_AGENT
#define LDS_WAIT() asm volatile("s_waitcnt lgkmcnt(0)" ::: "memory")
#define VM_WAIT() asm volatile("s_waitcnt vmcnt(0)" ::: "memory")
__device__ __forceinline__ unsigned long long rt() { return __builtin_amdgcn_s_memrealtime(); }
__device__ __forceinline__ unsigned f2bf(float f) { unsigned u = __builtin_bit_cast(unsigned, f); return (u + 0x7fffu + ((u >> 16) & 1u)) >> 16; }
__device__ __forceinline__ unsigned pk2(float lo, float hi) { return f2bf(lo) | (f2bf(hi) << 16); }
#define XB_TMO      128
#define XB_XCNT(j)  (256  + 64 * (j))
#define XB_XSUB(j)  (1280 + 64 * (j))
#define XB_XGEN(j)  (2304 + 64 * (j))
#define XB_TOP      3328
#define XB_TOPGEN   3392
#define XCD_BAR_WORDS 3456
#define XB_SPIN_CAP (1u << 18)

__device__ __forceinline__ unsigned xb_ld(unsigned* p)              { return __hip_atomic_load(p, __ATOMIC_RELAXED, __HIP_MEMORY_SCOPE_AGENT); }
__device__ __forceinline__ unsigned xb_add(unsigned* p, unsigned v) { return __hip_atomic_fetch_add(p, v, __ATOMIC_RELAXED, __HIP_MEMORY_SCOPE_AGENT); }
__device__ __forceinline__ unsigned xb_xcc_id() { return (unsigned)__builtin_amdgcn_s_getreg((3 << 11) | 20) & 0xFu; }
#define XB_SPIN(cond, bar) do { unsigned _sp = 0; while (cond) { __builtin_amdgcn_s_sleep(1); \
    if ((++_sp & 255u) == 0u) { if (xb_ld(&(bar)[XB_TMO])) break; if (_sp > XB_SPIN_CAP) { atomicAdd(&(bar)[XB_TMO], 1u); break; } } } } while (0)

struct XcdBarrier {
    unsigned* bar; unsigned x;
    volatile LAS unsigned* st;
};

__device__ __forceinline__ XcdBarrier xcd_barrier_post(unsigned* bar, volatile LAS unsigned* st) {
    XcdBarrier b; b.bar = bar; b.x = xb_xcc_id(); b.st = st;
    if (threadIdx.x == 0) (void)xb_add(&bar[XB_XCNT(b.x)], 1u);
    return b;
}
__device__ __forceinline__ void xcd_barrier_complete(unsigned* bar, unsigned x, unsigned& nloc, unsigned& nx) {
    const unsigned G = gridDim.x * gridDim.y * gridDim.z;
    unsigned sum, cnt, mine, sp = 0u;
    for (;;) {
        sum = 0u; cnt = 0u; mine = 0u;
#pragma unroll
        for (unsigned j = 0; j < 16; ++j) { const unsigned c = xb_ld(&bar[XB_XCNT(j)]); sum += c; cnt += (c > 0u) ? 1u : 0u; mine = (j == x) ? c : mine; }
        if (sum == G) break;
        __builtin_amdgcn_s_sleep(1);
        if ((++sp & 255u) == 0u) { if (xb_ld(&bar[XB_TMO])) break; if (sp > XB_SPIN_CAP) { atomicAdd(&bar[XB_TMO], 1u); break; } }
    }
    nloc = mine > 0u ? mine : 1u; nx = cnt > 0u ? cnt : 1u;
}

__device__ __forceinline__ void xcd_barrier(const XcdBarrier& b) {
    asm volatile("s_waitcnt vmcnt(0)" ::: "memory");
    __syncthreads();
    if (threadIdx.x == 0) {
        unsigned* bar = b.bar;
        __builtin_amdgcn_s_waitcnt(0);
        unsigned nloc = b.st[0], nx = b.st[1];
        if (nloc == 0u) { xcd_barrier_complete(bar, b.x, nloc, nx); b.st[0] = nloc; b.st[1] = nx; }
        const unsigned old = xb_add(&bar[XB_XSUB(b.x)], 1u);
        const unsigned gen = old / nloc;
        if (old + 1u == (gen + 1u) * nloc) {
            __builtin_amdgcn_fence(__ATOMIC_RELEASE, "agent");
            asm volatile("s_waitcnt vmcnt(0)" ::: "memory");
            const unsigned og = xb_add(&bar[XB_TOP], 1u);
            const unsigned tg = og / nx;
            if (og + 1u == (tg + 1u) * nx) xb_add(&bar[XB_TOPGEN], 1u);
            else XB_SPIN(xb_ld(&bar[XB_TOPGEN]) == tg, bar);
            __builtin_amdgcn_fence(__ATOMIC_ACQUIRE, "agent");
            xb_add(&bar[XB_XGEN(b.x)], 1u);
            asm volatile("s_waitcnt vmcnt(0)" ::: "memory");
        } else {
            XB_SPIN(xb_ld(&bar[XB_XGEN(b.x)]) == gen, bar);
            __builtin_amdgcn_fence(__ATOMIC_ACQUIRE, "agent");
            asm volatile("s_waitcnt vmcnt(0)" ::: "memory");
        }
    }
    __syncthreads();
}

constexpr int NWAVES = 8;
#ifndef MK_N_LAUNCHES
#define MK_N_LAUNCHES 1
#endif
constexpr int N_PHASES = 8;
constexpr int N_LAUNCHES = MK_N_LAUNCHES;

constexpr int BATCH = 8, SEQ = 4096, D = 1024, M = BATCH * SEQ;
constexpr int NPROJ = 2304, FF = 2816, NGU = 2 * FF, NMOD = 6144;
constexpr int NHEAD = 8, HD = 64, BLK = 128;
constexpr int C_Q = 0, C_K = 512, C_V = 640, C_GB = 768, C_GC = 1280, C_XC = 1792;
constexpr float EPS = 1e-6f;

constexpr size_t MiB = 1u << 20;
constexpr size_t WS_CTL = 0, CTL_ZERO_BYTES = 1 * MiB;
constexpr size_t WS_MOD = 1 * MiB;
constexpr size_t WS_BIAS1 = WS_MOD + 256 * 1024;
constexpr size_t WS_BIAS2 = WS_MOD + 512 * 1024;
constexpr size_t WS_RSTD1 = WS_MOD + 768 * 1024;
constexpr size_t WS_SS2 = 2 * MiB;
constexpr size_t WS_W1T = 4 * MiB;
constexpr size_t WS_WOT = 9 * MiB;
constexpr size_t WS_WGUT = 11 * MiB;
constexpr size_t WS_WDT = 22 * MiB;
constexpr size_t WS_A = 28 * MiB;
constexpr size_t WS_PROJ = 92 * MiB;
constexpr size_t WS_MERGED = 236 * MiB;
constexpr size_t WS_HID = 92 * MiB;
constexpr size_t WS_END = 300 * MiB;
static_assert(WS_BIAS2 + (size_t)8 * NGU * 4 <= WS_RSTD1 && WS_RSTD1 + (size_t)M * 4 <= WS_SS2 && WS_SS2 + (size_t)M * 64 <= WS_W1T, "ws map 1");
static_assert(WS_W1T + (size_t)NPROJ * D * 2 <= WS_WOT && WS_WOT + (size_t)D * D * 2 <= WS_WGUT && WS_WGUT + (size_t)NGU * D * 2 <= WS_WDT && WS_WDT + (size_t)D * FF * 2 <= WS_A, "ws map 2");
static_assert(WS_A + (size_t)M * D * 2 <= WS_PROJ && WS_PROJ + (size_t)M * NPROJ * 2 <= WS_MERGED && WS_MERGED + (size_t)M * D * 2 <= WS_END && WS_HID + (size_t)M * FF * 2 <= WS_END, "ws map 3");
constexpr int CW_TMO = 0, CW_CODE = 1;
constexpr int CW_BAR = 4096;

constexpr int RING_OFF = 0, RING_BYTES = 131072;
constexpr int LDSCTL_OFF = RING_BYTES, MISC_OFF = LDSCTL_OFF + 320;
constexpr int MIX_OFF = RING_BYTES + 1024;
constexpr int LDS_BYTES = 147456;
static_assert(MISC_OFF + 128 <= MIX_OFF && MIX_OFF + 6144 <= LDS_BYTES, "LDS map");

__device__ const unsigned char T5_BUCKET[128] = {0,1,2,3,4,5,6,7,8,9,10,11,12,13,14,15,16,16,16,17,17,18,18,18,19,19,19,20,20,20,20,21,21,21,21,22,22,22,22,22,23,23,23,23,23,23,24,24,24,24,24,24,25,25,25,25,25,25,25,26,26,26,26,26,26,26,26,27,27,27,27,27,27,27,27,27,27,28,28,28,28,28,28,28,28,28,28,29,29,29,29,29,29,29,29,29,29,29,29,30,30,30,30,30,30,30,30,30,30,30,30,30,30,31,31,31,31,31,31,31,31,31,31,31,31,31,31,31};

struct Frame {
    LAS unsigned char* lds;
    volatile LAS unsigned* MISC;
    gu32* ctl;
    int tid, lane, wave;
    int vcu, G;
    const float *x, *c, *rel_bias, *w_ada, *b_ada, *g_norm1, *w_in, *sinks, *conv_w, *g_attn_out, *g_conv_out, *w_out, *g_norm2, *w_gu, *w_down, *g_final;
    float* out;
    float *mod, *bias1, *bias2, *rstd1, *ss2;
    bf16 *W1t, *Wot, *Wgut, *Wdt, *A, *PROJ, *MERGED, *HID;
};

__device__ __forceinline__ float wave_sum(float v) {
#pragma unroll
    for (int o = 1; o < 64; o <<= 1) v += __shfl_xor(v, o);
    return v;
}
__device__ __forceinline__ float bf_lo(unsigned w) { return __uint_as_float(w << 16); }
__device__ __forceinline__ float bf_hi(unsigned w) { return __uint_as_float(w & 0xffff0000u); }
__device__ __forceinline__ void unpack8(const v4u w, float* f) { f[0] = bf_lo(w.x); f[1] = bf_hi(w.x); f[2] = bf_lo(w.y); f[3] = bf_hi(w.y); f[4] = bf_lo(w.z); f[5] = bf_hi(w.z); f[6] = bf_lo(w.w); f[7] = bf_hi(w.w); }

__device__ __forceinline__ void p0_adaln(Frame& F, int chunk) {
    LAS float* sc = (LAS float*)(F.lds + RING_OFF);
    LAS float* red = (LAS float*)(F.lds + RING_OFF + 32768);
    for (int i = F.tid; i < BATCH * D; i += NWAVES * 64) { const float v = F.c[i]; sc[i] = v / (1.0f + expf(-v)); }
    __syncthreads();
    const int col = chunk * 64 + F.lane, kq = F.wave;
    float acc[BATCH];
#pragma unroll
    for (int b = 0; b < BATCH; ++b) acc[b] = 0.f;
    const float* wp = F.w_ada + (size_t)kq * NMOD + col;
#pragma unroll 8
    for (int i = 0; i < D / NWAVES; ++i) { const float w = wp[(size_t)i * NWAVES * NMOD]; const int k = kq + NWAVES * i;
#pragma unroll
        for (int b = 0; b < BATCH; ++b) acc[b] += sc[b * D + k] * w; }
#pragma unroll
    for (int b = 0; b < BATCH; ++b) red[(kq * BATCH + b) * 64 + F.lane] = acc[b];
    __syncthreads();
    { const int b = F.wave; float s = 0.f;
#pragma unroll
      for (int w = 0; w < NWAVES; ++w) s += red[(w * BATCH + b) * 64 + F.lane];
      F.mod[(size_t)b * NMOD + col] = s + F.b_ada[col]; }
    __syncthreads();
}
__device__ __forceinline__ void p0_transpose_item(const float* W, int K, int N, bf16* WT, int k0, int n0, int drow0, LAS float* scr, int lane) {
#pragma unroll 8
    for (int i = 0; i < 32; ++i) { const int kk = 2 * i + (lane >> 5); scr[kk * 33 + (lane & 31)] = W[(size_t)(k0 + kk) * N + n0 + (lane & 31)]; }
    LDS_WAIT(); asm volatile("" ::: "memory");
    const int c = lane & 7;
#pragma unroll
    for (int j = 0; j < 4; ++j) { const int n = (lane >> 3) + 8 * j; const LAS float* s = scr + (8 * c) * 33 + n;
        v4u o; o.x = pk2(s[0 * 33], s[1 * 33]); o.y = pk2(s[2 * 33], s[3 * 33]); o.z = pk2(s[4 * 33], s[5 * 33]); o.w = pk2(s[6 * 33], s[7 * 33]);
        *(GAS v4u*)(WT + (size_t)(drow0 + n) * K + k0 + 8 * c) = o; }
    LDS_WAIT(); asm volatile("" ::: "memory");
}
__device__ __forceinline__ void p0_prologue(Frame& F) {
    if ((int)blockIdx.x < NMOD / 64) p0_adaln(F, (int)blockIdx.x);
    LAS float* scr = (LAS float*)(F.lds + RING_OFF + F.wave * 16384);
    const int gw = F.vcu * NWAVES + F.wave, NGW = F.G * NWAVES;
    constexpr int I_IN = (D / 64) * (NPROJ / 32), I_OUT = (D / 64) * (D / 32), I_GU = (D / 64) * (NGU / 32), I_DN = (FF / 64) * (D / 32);
    constexpr int NITEMS = I_IN + I_OUT + I_GU + I_DN;
    for (int it = gw; it < NITEMS; it += NGW) {
        int r = it;
        if (r < I_IN) { const int nb = NPROJ / 32, kb = r / nb, n0 = 32 * (r % nb); p0_transpose_item(F.w_in, D, NPROJ, F.W1t, 64 * kb, n0, n0, scr, F.lane); continue; } r -= I_IN;
        if (r < I_OUT) { const int nb = D / 32, kb = r / nb, n0 = 32 * (r % nb); p0_transpose_item(F.w_out, D, D, F.Wot, 64 * kb, n0, n0, scr, F.lane); continue; } r -= I_OUT;
        if (r < I_GU) { const int nb = NGU / 32, kb = r / nb, n0 = 32 * (r % nb);
            const int drow0 = (n0 < FF) ? 256 * (n0 >> 7) + (n0 & 127) : 256 * ((n0 - FF) >> 7) + 128 + ((n0 - FF) & 127);
            p0_transpose_item(F.w_gu, D, NGU, F.Wgut, 64 * kb, n0, drow0, scr, F.lane); continue; } r -= I_GU;
        { const int nb = D / 32, kb = r / nb, n0 = 32 * (r % nb); p0_transpose_item(F.w_down, FF, D, F.Wdt, 64 * kb, n0, n0, scr, F.lane); }
    }
}

__device__ __forceinline__ void p1_norm(Frame& F) {
    LAS float* s1 = (LAS float*)(F.lds + RING_OFF); LAS float* s2 = s1 + BATCH * D;
    for (int i = F.tid; i < BATCH * D; i += NWAVES * 64) { const int b = i >> 10, k = i & 1023; s1[i] = F.mod[(size_t)b * NMOD + k]; s2[i] = F.mod[(size_t)b * NMOD + 3072 + k]; }
    __syncthreads();
    const int gw = F.vcu * NWAVES + F.wave, NGW = F.G * NWAVES;
    for (int m = gw; m < M; m += NGW) {
        const int b = m >> 12;
        const GAS f32x4* xr = (const GAS f32x4*)(F.x + (size_t)m * D) + F.lane;
        f32x4 v[4]; float s = 0.f;
#pragma unroll
        for (int j = 0; j < 4; ++j) { v[j] = xr[64 * j]; s += (v[j].x * v[j].x + v[j].y * v[j].y) + (v[j].z * v[j].z + v[j].w * v[j].w); }
        const float rstd = 1.0f / sqrtf(wave_sum(s) * (1.0f / D) + EPS);
        if (F.lane == 0) F.rstd1[m] = rstd;
        const GAS f32x4* gp = (const GAS f32x4*)F.g_norm1 + F.lane; const GAS f32x4* sp = (const GAS f32x4*)(F.mod + (size_t)b * NMOD + 1024) + F.lane;
        GAS unsigned long long* o8 = (GAS unsigned long long*)(F.A + (size_t)m * D) + F.lane;
#pragma unroll
        for (int j = 0; j < 4; ++j) { const f32x4 g = gp[64 * j] * (sp[64 * j] + 1.0f); const f32x4 w = v[j] * g;
            o8[64 * j] = (unsigned long long)pk2(w.x, w.y) | ((unsigned long long)pk2(w.z, w.w) << 32); }
    }
    for (int it = gw; it < NPROJ + NGU; it += NGW) {
        const bf16* wrow; LAS float* sh; float* dst; int ld;
        if (it < NPROJ) { wrow = F.W1t + (size_t)it * D; sh = s1; dst = F.bias1 + it; ld = NPROJ; } else { const int p = it - NPROJ; wrow = F.Wgut + (size_t)p * D; sh = s2; dst = F.bias2 + p; ld = NGU; }
        float wf[2][8];
#pragma unroll
        for (int j = 0; j < 2; ++j) { const v4u w = *(const GAS v4u*)(wrow + 512 * j + 8 * F.lane); unpack8(w, wf[j]); }
#pragma unroll
        for (int b = 0; b < BATCH; ++b) { float s = 0.f;
#pragma unroll
            for (int j = 0; j < 2; ++j)
#pragma unroll
                for (int e = 0; e < 8; ++e) s += wf[j][e] * sh[b * D + 512 * j + 8 * F.lane + e];
            s = wave_sum(s); if (F.lane == 0) dst[(size_t)b * ld] = s; }
    }
    __syncthreads();
}

typedef float f32x16 __attribute__((ext_vector_type(16)));
typedef short s16x4 __attribute__((ext_vector_type(4)));
typedef float f32x2_t __attribute__((ext_vector_type(2))); typedef __bf16 bf16x2_t __attribute__((ext_vector_type(2)));
__device__ __forceinline__ unsigned cvtpk(float lo, float hi) { f32x2_t v = {lo, hi}; bf16x2_t b = __builtin_convertvector(v, bf16x2_t); return __builtin_bit_cast(unsigned, b); }
__device__ __forceinline__ s16x4 vtr(const LAS unsigned char* p) { return __builtin_bit_cast(s16x4, __builtin_amdgcn_ds_read_tr16_b64_v4i16((LAS s16x4*)p)); }
constexpr int MIX_BT = MIX_OFF + 128;
constexpr int MIX_SSQ = MIX_OFF + 4352;
static_assert(MIX_SSQ + 2048 <= LDS_BYTES, "mixer LDS");
__device__ __forceinline__ void p3_mixer(Frame& F) {
    LAS unsigned char* Kimg = F.lds + RING_OFF;
    LAS unsigned char* Vimg = F.lds + RING_OFF + 65536;
    LAS float* btab = (LAS float*)(F.lds + MIX_BT);
    LAS float* ssq = (LAS float*)(F.lds + MIX_SSQ);
    constexpr float LOG2E = 1.4426950408889634f, SC = 0.125f * LOG2E;
    for (int i = F.tid; i < 1024; i += NWAVES * 64) { const int h = i >> 7, dist = i & 127; btab[i] = F.rel_bias[(int)T5_BUCKET[dist] * NHEAD + h] * LOG2E; }
    const int lane = F.lane, r = lane & 31, hi = lane >> 5, h = F.wave, kvh = h >> 2;
    const float sink2 = F.sinks[h] * LOG2E;
    for (int unit = (int)blockIdx.x; unit < BATCH * (SEQ / BLK); unit += F.G) {
        const int b = unit >> 5, n = unit & 31; const size_t R0 = (size_t)b * SEQ + (size_t)n * BLK;
        __syncthreads();
        for (int idx = F.tid; idx < 8192; idx += NWAVES * 64) {
            const int which = idx >> 12, kv = (idx >> 11) & 1, j = (idx >> 3) & 255, c8 = idx & 7;
            v4u val = (v4u){0u, 0u, 0u, 0u};
            if (n > 0 || j >= BLK) val = *(const GAS v4u*)(F.PROJ + (R0 + j - BLK) * NPROJ + C_K + which * 128 + kv * HD + c8 * 8);
            if (which == 0) *(LAS v4u*)(Kimg + kv * 32768 + (((j >> 5) * 4 + (c8 >> 1)) * 2 + (c8 & 1)) * 512 + (j & 31) * 16) = val;
            else            *(LAS v4u*)(Vimg + kv * 32768 + ((j >> 2) * 4 + (c8 >> 1)) * 128 + (j & 3) * 32 + (c8 & 1) * 16) = val;
        }
        __syncthreads();
        const LAS unsigned char* Kb = Kimg + kvh * 32768 + hi * 512 + r * 16;
        const LAS unsigned char* Vb = Vimg + kvh * 32768 + hi * 512 + ((lane >> 4) & 1) * 128 + (lane & 15) * 8;
        const LAS float* bt = btab + h * 128 + r - 4 * hi;
        const bool lowvalid = (n > 0);
        for (int qt = 0; qt < 4; ++qt) {
            const bf16* qp = F.PROJ + (R0 + 32 * qt + r) * NPROJ + C_Q + h * HD + 8 * hi;
            bf16x8 qf[4];
#pragma unroll
            for (int ks = 0; ks < 4; ++ks) qf[ks] = *(const GAS bf16x8*)(qp + 16 * ks);
            f32x16 st[5];
#pragma unroll
            for (int dl = 0; dl < 5; ++dl) {
#pragma unroll
                for (int e = 0; e < 16; ++e) st[dl][e] = 0.f;
                const LAS unsigned char* kp = Kb + (qt + dl) * 4096;
#pragma unroll
                for (int ks = 0; ks < 4; ++ks) { const bf16x8 kf = *(const LAS bf16x8*)(kp + ks * 1024); st[dl] = __builtin_amdgcn_mfma_f32_32x32x16_bf16(kf, qf[ks], st[dl], 0, 0, 0); }
            }
            float mx = sink2;
#pragma unroll
            for (int dl = 0; dl < 5; ++dl) { const bool tv = lowvalid || (qt + dl >= 4);
#pragma unroll
                for (int e = 0; e < 16; ++e) { const int c = (e & 3) + 8 * (e >> 2); float t = st[dl][e] * SC + bt[128 - 32 * dl - c];
                    bool valid = tv; if (dl == 0) valid = valid && (c + 4 * hi > r); if (dl == 4) valid = valid && (c + 4 * hi <= r);
                    t = valid ? t : -1e30f; st[dl][e] = t; mx = fmaxf(mx, t); } }
            mx = fmaxf(mx, __shfl_xor(mx, 32));
            float sum = 0.f;
#pragma unroll
            for (int dl = 0; dl < 5; ++dl)
#pragma unroll
                for (int e = 0; e < 16; ++e) { const float p = __builtin_amdgcn_exp2f(st[dl][e] - mx); st[dl][e] = p; sum += p; }
            sum += __shfl_xor(sum, 32);
            const float l = sum + __builtin_amdgcn_exp2f(sink2 - mx);
            f32x16 ot[2];
#pragma unroll
            for (int e = 0; e < 16; ++e) { ot[0][e] = 0.f; ot[1][e] = 0.f; }
#pragma unroll
            for (int dl = 0; dl < 5; ++dl)
#pragma unroll
                for (int s = 0; s < 2; ++s) {
                    v4u pw; pw.x = cvtpk(st[dl][8 * s + 0], st[dl][8 * s + 1]); pw.y = cvtpk(st[dl][8 * s + 2], st[dl][8 * s + 3]); pw.z = cvtpk(st[dl][8 * s + 4], st[dl][8 * s + 5]); pw.w = cvtpk(st[dl][8 * s + 6], st[dl][8 * s + 7]);
                    const bf16x8 pb = __builtin_bit_cast(bf16x8, pw);
                    const LAS unsigned char* vp = Vb + ((qt + dl) * 8 + 4 * s) * 512;
#pragma unroll
                    for (int d0 = 0; d0 < 2; ++d0) { const s16x4 lo = vtr(vp + d0 * 256), up = vtr(vp + d0 * 256 + 1024);
                        const bf16x8 vf = __builtin_shufflevector(lo, up, 0, 1, 2, 3, 4, 5, 6, 7);
                        ot[d0] = __builtin_amdgcn_mfma_f32_32x32x16_bf16(vf, pb, ot[d0], 0, 0, 0); }
                }
            const float inv = 1.0f / l; float ss = 0.f;
#pragma unroll
            for (int d0 = 0; d0 < 2; ++d0)
#pragma unroll
                for (int e = 0; e < 16; ++e) { const float o = ot[d0][e] * inv; ot[d0][e] = o; ss += o * o; }
            ss += __shfl_xor(ss, 32);
            LAS float* sq = ssq + (qt & 1) * 256;
            if (hi == 0) sq[h * 32 + r] = ss;
            __syncthreads();
            float tot = 0.f;
#pragma unroll
            for (int hh = 0; hh < NHEAD; ++hh) tot += sq[hh * 32 + r];
            const float rstd = 1.0f / sqrtf(tot * (1.0f / 512.0f) + EPS);
            unsigned char* op = (unsigned char*)(F.MERGED + (R0 + 32 * qt + r) * D + h * HD) + hi * 16;
            const float* gp = F.g_attn_out + h * HD + 4 * hi;
#pragma unroll
            for (int d0 = 0; d0 < 2; ++d0)
#pragma unroll
                for (int pr = 0; pr < 2; ++pr) {
                    const int ga = 2 * pr, gb = 2 * pr + 1;
                    const f32x4 wa = *(const GAS f32x4*)(gp + 32 * d0 + 8 * ga) * rstd, wb = *(const GAS f32x4*)(gp + 32 * d0 + 8 * gb) * rstd;
                    unsigned ax = cvtpk(ot[d0][4 * ga + 0] * wa.x, ot[d0][4 * ga + 1] * wa.y), ay = cvtpk(ot[d0][4 * ga + 2] * wa.z, ot[d0][4 * ga + 3] * wa.w);
                    unsigned bx = cvtpk(ot[d0][4 * gb + 0] * wb.x, ot[d0][4 * gb + 1] * wb.y), by = cvtpk(ot[d0][4 * gb + 2] * wb.z, ot[d0][4 * gb + 3] * wb.w);
                    { auto rr = __builtin_amdgcn_permlane32_swap(ax, bx, false, false); ax = rr[0]; bx = rr[1]; }
                    { auto rr = __builtin_amdgcn_permlane32_swap(ay, by, false, false); ay = rr[0]; by = rr[1]; }
                    *(GAS v4u*)(op + (32 * d0 + 16 * pr) * 2) = (v4u){ax, ay, bx, by};
                }
        }
        {
            const int c0 = 8 * F.lane, tt0 = 16 * F.wave;
            float w0[8], w1[8], w2[8], gco[8], u1[8], u2[8];
#pragma unroll
            for (int e = 0; e < 8; ++e) { w0[e] = F.conv_w[c0 + e]; w1[e] = F.conv_w[512 + c0 + e]; w2[e] = F.conv_w[1024 + c0 + e]; gco[e] = F.g_conv_out[c0 + e]; u1[e] = 0.f; u2[e] = 0.f; }
            for (int pre = 2; pre >= 1; --pre) {
                const int pos = n * BLK + tt0 - pre;
                if (pos >= 0) { const size_t r = R0 + tt0 - pre; const v4u cw = *(const GAS v4u*)(F.PROJ + r * NPROJ + C_GC + c0), xw = *(const GAS v4u*)(F.PROJ + r * NPROJ + C_XC + c0);
                    float cf[8], xf[8]; unpack8(cw, cf); unpack8(xw, xf);
#pragma unroll
                    for (int e = 0; e < 8; ++e) { if (pre == 2) u2[e] = cf[e] * xf[e]; else u1[e] = cf[e] * xf[e]; } }
            }
            for (int i = 0; i < 16; ++i) {
                const size_t r = R0 + tt0 + i;
                const v4u bw = *(const GAS v4u*)(F.PROJ + r * NPROJ + C_GB + c0), cw = *(const GAS v4u*)(F.PROJ + r * NPROJ + C_GC + c0), xw = *(const GAS v4u*)(F.PROJ + r * NPROJ + C_XC + c0);
                float bfv[8], cf[8], xf[8], y[8]; unpack8(bw, bfv); unpack8(cw, cf); unpack8(xw, xf);
                float ss = 0.f;
#pragma unroll
                for (int e = 0; e < 8; ++e) { const float u0 = cf[e] * xf[e]; y[e] = bfv[e] * (w0[e] * u2[e] + w1[e] * u1[e] + w2[e] * u0); ss += y[e] * y[e]; u2[e] = u1[e]; u1[e] = u0; }
                const float rstd = 1.0f / sqrtf(wave_sum(ss) * (1.0f / 512.0f) + EPS);
                v4u w; w.x = pk2(y[0] * rstd * gco[0], y[1] * rstd * gco[1]); w.y = pk2(y[2] * rstd * gco[2], y[3] * rstd * gco[3]);
                w.z = pk2(y[4] * rstd * gco[4], y[5] * rstd * gco[5]); w.w = pk2(y[6] * rstd * gco[6], y[7] * rstd * gco[7]);
                *(GAS v4u*)(F.MERGED + r * D + 512 + c0) = w;
            }
        }
    }
    __syncthreads();
}

__device__ __forceinline__ void p7_final(Frame& F) {
    const int gw = F.vcu * NWAVES + F.wave, NGW = F.G * NWAVES;
    for (int m = gw; m < M; m += NGW) {
        GAS f32x4* xr = (GAS f32x4*)(F.out + (size_t)m * D) + F.lane;
        f32x4 v[4]; float s = 0.f;
#pragma unroll
        for (int j = 0; j < 4; ++j) { v[j] = xr[64 * j]; s += (v[j].x * v[j].x + v[j].y * v[j].y) + (v[j].z * v[j].z + v[j].w * v[j].w); }
        const float rstd = 1.0f / sqrtf(wave_sum(s) * (1.0f / D) + EPS);
        const GAS f32x4* gp = (const GAS f32x4*)F.g_final + F.lane;
#pragma unroll
        for (int j = 0; j < 4; ++j) xr[64 * j] = v[j] * rstd * gp[64 * j];
    }
}

struct Args { const float* in[16]; float* out; unsigned char* ws; int ph_lo, ph_hi; };
__global__ void __launch_bounds__(NWAVES * 64, 2) hymba_fwd(Args args) {
    extern __shared__ __attribute__((aligned(16))) unsigned char lds[];
    Frame F;
    F.lds = (LAS unsigned char*)lds;
    F.MISC = (volatile LAS unsigned*)(F.lds + MISC_OFF);
    F.tid = threadIdx.x; F.lane = F.tid & 63; F.wave = __builtin_amdgcn_readfirstlane(F.tid >> 6);
    F.G = gridDim.x; { const int bx = blockIdx.x; F.vcu = (F.G % 8 == 0) ? (bx % 8) * (F.G / 8) + bx / 8 : bx; }
    unsigned char* ws = args.ws;
    F.ctl = (gu32*)(ws + WS_CTL);
    F.x = args.in[0]; F.c = args.in[1]; F.rel_bias = args.in[2]; F.w_ada = args.in[3]; F.b_ada = args.in[4]; F.g_norm1 = args.in[5]; F.w_in = args.in[6]; F.sinks = args.in[7];
    F.conv_w = args.in[8]; F.g_attn_out = args.in[9]; F.g_conv_out = args.in[10]; F.w_out = args.in[11]; F.g_norm2 = args.in[12]; F.w_gu = args.in[13]; F.w_down = args.in[14]; F.g_final = args.in[15];
    F.out = args.out;
    F.mod = (float*)(ws + WS_MOD); F.bias1 = (float*)(ws + WS_BIAS1); F.bias2 = (float*)(ws + WS_BIAS2); F.rstd1 = (float*)(ws + WS_RSTD1); F.ss2 = (float*)(ws + WS_SS2);
    F.W1t = (bf16*)(ws + WS_W1T); F.Wot = (bf16*)(ws + WS_WOT); F.Wgut = (bf16*)(ws + WS_WGUT); F.Wdt = (bf16*)(ws + WS_WDT);
    F.A = (bf16*)(ws + WS_A); F.PROJ = (bf16*)(ws + WS_PROJ); F.MERGED = (bf16*)(ws + WS_MERGED); F.HID = (bf16*)(ws + WS_HID);
    for (int u = F.tid; u < (MIX_OFF - LDSCTL_OFF) / 4; u += NWAVES * 64) ((LAS unsigned*)(F.lds + LDSCTL_OFF))[u] = 0u;
    __syncthreads();
    XcdBarrier bar; bar.bar = (unsigned*)(F.ctl + CW_BAR); bar.x = 0; bar.st = nullptr;
    if (N_LAUNCHES == 1) bar = xcd_barrier_post((unsigned*)(F.ctl + CW_BAR), F.MISC + 8);
#define GRID_BAR() do { if (N_LAUNCHES == 1) xcd_barrier(bar); } while (0)
    const int lo = args.ph_lo, hi = args.ph_hi;
#define IN(k) (lo <= (k) && (k) < hi)
#ifndef REPEAT_PHASE
#define REPEAT_PHASE -1
#endif
#define REP(k) for (int rep_ = 0; rep_ < ((k) == REPEAT_PHASE ? 2 : 1); ++rep_)
#define BOTH(k) (IN(k) && IN((k) + 1))

    if (IN(0)) REP(0) { p0_prologue(F); if (BOTH(0)) GRID_BAR(); }
    if (IN(1)) REP(1) { p1_norm(F); if (BOTH(1)) GRID_BAR(); }
    if (IN(2)) REP(2) {
        pg8::Gemm g{F.A, F.W1t, M, NPROJ, D}; pg8::StaticOrder S; S.init(M, NPROJ, F.G, (int)blockIdx.x);
        pg8::EpiProj E{F.PROJ, F.rstd1, F.bias1};
        pg8::gemm_phase<pg8::EpiProj, pg8::StaticOrder, true, true>(F.lds + RING_OFF, g, S, E);
        if (BOTH(2)) GRID_BAR();
    }
    if (IN(3)) REP(3) { p3_mixer(F); if (BOTH(3)) GRID_BAR(); }
    if (IN(4)) REP(4) {
        pg8::Gemm g{F.MERGED, F.Wot, M, D, D}; pg8::StaticOrder S; S.init(M, D, F.G, (int)blockIdx.x);
        pg8::EpiOut E{F.x, F.out, F.A, F.mod, F.g_norm2, F.ss2};
        pg8::gemm_phase<pg8::EpiOut, pg8::StaticOrder, true, true>(F.lds + RING_OFF, g, S, E);
        if (BOTH(4)) GRID_BAR();
    }
    if (IN(5)) REP(5) {
        pg8::Gemm g{F.A, F.Wgut, M, NGU, D}; pg8::StaticOrder S; S.init(M, NGU, F.G, (int)blockIdx.x);
        pg8::EpiGU E{F.HID, F.ss2, F.bias2};
        pg8::gemm_phase<pg8::EpiGU, pg8::StaticOrder, true, true>(F.lds + RING_OFF, g, S, E);
        if (BOTH(5)) GRID_BAR();
    }
    if (IN(6)) {
        pg8::Gemm g{F.HID, F.Wdt, M, D, FF}; pg8::StaticOrder S; S.init(M, D, F.G, (int)blockIdx.x);
        pg8::EpiDown E{F.out, F.mod};
        pg8::gemm_phase<pg8::EpiDown, pg8::StaticOrder, true, true>(F.lds + RING_OFF, g, S, E);
        if (BOTH(6)) GRID_BAR();
    }
    if (IN(7)) { p7_final(F); }
#undef IN
#undef BOTH
}

extern "C" void kernel_launch(void* const* d_in, const int* in_sizes, int n_in, void* d_out, int out_size, void* d_ws, size_t ws_size, hipStream_t stream) {
    static int grid = 0;
    if (grid == 0) {
        if (n_in != 16 || in_sizes[0] != M * D || out_size != M * D || ws_size < WS_END) { fprintf(stderr, "kernel_launch: unexpected shapes (n_in %d, in0 %d, out %d, ws %zu); nothing launched\n", n_in, n_in > 0 ? in_sizes[0] : -1, out_size, ws_size); grid = -1; return; }
        int dev = 0, cus = 0, per_cu = 0;
        if (hipGetDevice(&dev) != hipSuccess || hipDeviceGetAttribute(&cus, hipDeviceAttributeMultiprocessorCount, dev) != hipSuccess) { grid = -1; return; }
        if (hipFuncSetAttribute((const void*)hymba_fwd, hipFuncAttributeMaxDynamicSharedMemorySize, LDS_BYTES) != hipSuccess) { fprintf(stderr, "kernel_launch: hipFuncSetAttribute failed\n"); grid = -1; return; }
        if (hipOccupancyMaxActiveBlocksPerMultiprocessor(&per_cu, (const void*)hymba_fwd, NWAVES * 64, LDS_BYTES) != hipSuccess || per_cu < 1) { fprintf(stderr, "kernel_launch: occupancy query says %d blocks per CU\n", per_cu); }
        (void)hipGetLastError();
        grid = cus;
    }
    if (grid < 0) return;
    if (hipMemsetAsync((char*)d_ws + WS_CTL, 0, CTL_ZERO_BYTES, stream) != hipSuccess) return;
    Args a{};
    for (int i = 0; i < 16; ++i) a.in[i] = (const float*)d_in[i];
    a.out = (float*)d_out; a.ws = (unsigned char*)d_ws;
    if (N_LAUNCHES == 1) { a.ph_lo = 0; a.ph_hi = N_PHASES; hipLaunchKernelGGL(hymba_fwd, dim3(grid), dim3(NWAVES * 64), LDS_BYTES, stream, a); }
    else for (int li = 0; li < N_PHASES; ++li) { a.ph_lo = li; a.ph_hi = li + 1; hipLaunchKernelGGL(hymba_fwd, dim3(grid), dim3(NWAVES * 64), LDS_BYTES, stream, a); }
}
```
